# Optimizing an MI355X kernel written in HIP

```python
import math
import jax, jax.numpy as jnp
from jax import lax
import numpy as np

D_MODEL = 2048
BATCH = 1
SEQ = 8192
DEPTH = 2

GRID_W = 64
HEAD_DIM = 128
ROPE_THETA = 500000.0
ROPE_DIM = HEAD_DIM // 4
NORM_EPS = 1e-6

NA_HEADS = 8
NA_KH_MAX = 8
NA_KW = 16

SW_Q_HEADS = 8
SW_KV_HEADS = 2
SW_WINDOW = 128
SW_BLOCK = 128

DIFF_HEADS = 8
Q_BLOCK = 128

MEM_LEN = 256
MEM_HEADS = 4

D_FF = 4 * D_MODEL

NA_W = NA_HEADS * HEAD_DIM
SW_QW = SW_Q_HEADS * HEAD_DIM
SW_KVW = SW_KV_HEADS * HEAD_DIM
EVEN_IN = 3 * NA_W + SW_QW + 2 * SW_KVW
EVEN_OUT = NA_W + SW_QW
DIFF_W = DIFF_HEADS * 2 * HEAD_DIM
ODD_IN = 3 * DIFF_W
MEM_W = MEM_HEADS * HEAD_DIM
N_EVEN = (DEPTH + 1) // 2
N_ODD = DEPTH // 2

kernel_name = "hybrid_natten_swa_diffattn_encoder"


def rms_norm(x, g):
    xf = x.astype(jnp.float32)
    y = xf * lax.rsqrt(jnp.mean(xf * xf, axis=-1, keepdims=True) + NORM_EPS)
    return (y * g.astype(jnp.float32)).astype(x.dtype)


def rope_tables(seq):
    inv = 1.0 / (ROPE_THETA ** (jnp.arange(0, ROPE_DIM, 2, dtype=jnp.float32) / ROPE_DIM))
    ang = jnp.arange(seq, dtype=jnp.float32)[:, None] * inv[None, :]
    return jnp.cos(ang), jnp.sin(ang)


def partial_rope(x, cos, sin):
    half = ROPE_DIM // 2
    x1 = x[..., :half].astype(jnp.float32)
    x2 = x[..., half:ROPE_DIM].astype(jnp.float32)
    c = cos[None, :, None, :]
    s = sin[None, :, None, :]
    r1 = (x1 * c - x2 * s).astype(x.dtype)
    r2 = (x2 * c + x1 * s).astype(x.dtype)
    return jnp.concatenate([r1, r2, x[..., ROPE_DIM:]], axis=-1)


def neighbourhood_attention(q, k, v, rpb):
    B, S, H, dh = q.shape
    rows = S // GRID_W
    kh = min(NA_KH_MAX, rows)
    kw = NA_KW
    qg = q.reshape(B, rows, GRID_W, H, dh)
    kg = k.reshape(B, rows, GRID_W, H, dh)
    vg = v.reshape(B, rows, GRID_W, H, dh)
    col = jnp.arange(GRID_W)
    col_start = jnp.clip(col - kw // 2, 0, GRID_W - kw)
    col_idx = col_start[:, None] + jnp.arange(kw)[None, :]
    col_off = col_idx - col[:, None] + (NA_KW - 1)
    scale = dh ** -0.5

    def one_row(i):
        rs = jnp.clip(i - kh // 2, 0, rows - kh)
        k_band = lax.dynamic_slice_in_dim(kg, rs, kh, axis=1)
        v_band = lax.dynamic_slice_in_dim(vg, rs, kh, axis=1)
        k_win = jnp.take(k_band, col_idx, axis=2)
        v_win = jnp.take(v_band, col_idx, axis=2)
        q_row = lax.dynamic_index_in_dim(qg, i, axis=1, keepdims=False)
        s = jnp.einsum('bjhd,brjchd->bhjrc', q_row, k_win).astype(jnp.float32) * scale
        row_off = rs + jnp.arange(kh) - i + (NA_KH_MAX - 1)
        bias = rpb[:, row_off[:, None, None], col_off[None, :, :]]
        s = s + jnp.transpose(bias, (0, 2, 1, 3))[None].astype(jnp.float32)
        p = jax.nn.softmax(s.reshape(B, H, GRID_W, kh * kw), axis=-1)
        p = p.reshape(B, H, GRID_W, kh, kw).astype(v.dtype)
        return jnp.einsum('bhjrc,brjchd->bjhd', p, v_win)

    out = lax.map(one_row, jnp.arange(rows))
    return jnp.transpose(out, (1, 0, 2, 3, 4)).reshape(B, S, H, dh)


def sliding_window_gqa(q, k, v, sinks, cos, sin):
    B, S, Hq, dh = q.shape
    Hkv = k.shape[2]
    G = Hq // Hkv
    nb = S // SW_BLOCK
    q = partial_rope(q, cos, sin)
    k = partial_rope(k, cos, sin)
    pad = ((0, 0), (SW_BLOCK, SW_BLOCK), (0, 0), (0, 0))
    kp = jnp.pad(k, pad).reshape(B, nb + 2, SW_BLOCK, Hkv, dh)
    vp = jnp.pad(v, pad).reshape(B, nb + 2, SW_BLOCK, Hkv, dh)
    k_band = jnp.concatenate([kp[:, :-2], kp[:, 1:-1], kp[:, 2:]], axis=2)
    v_band = jnp.concatenate([vp[:, :-2], vp[:, 1:-1], vp[:, 2:]], axis=2)
    qb = q.reshape(B, nb, SW_BLOCK, Hkv, G, dh)
    s = jnp.einsum('bnqkgd,bnckd->bnkgqc', qb, k_band).astype(jnp.float32) * (dh ** -0.5)
    blk = jnp.arange(nb)[:, None] * SW_BLOCK
    qpos = blk + jnp.arange(SW_BLOCK)[None, :]
    kpos = blk - SW_BLOCK + jnp.arange(3 * SW_BLOCK)[None, :]
    kp_b = kpos[:, None, :]
    valid = (jnp.abs(qpos[:, :, None] - kp_b) <= SW_WINDOW) & (kp_b >= 0) & (kp_b < S)
    s = jnp.where(valid[None, :, None, None, :, :], s, -jnp.inf)
    sink = sinks.astype(jnp.float32).reshape(Hkv, G)[None, None, :, :, None, None]
    m = jnp.maximum(jnp.max(s, axis=-1, keepdims=True), sink)
    p = jnp.exp(s - m)
    denom = jnp.sum(p, axis=-1, keepdims=True) + jnp.exp(sink - m)
    p = (p / denom).astype(v.dtype)
    o = jnp.einsum('bnkgqc,bnckd->bnqkgd', p, v_band)
    return o.reshape(B, S, Hq, dh)


def differential_attention(q, k, v, lam_q1, lam_k1, lam_q2, lam_k2, subln_g, lambda_init, cos, sin):
    B, S, H, _, dh = q.shape
    q = partial_rope(q.reshape(B, S, H * 2, dh), cos, sin).reshape(B, S, H, 2, dh)
    k = partial_rope(k.reshape(B, S, H * 2, dh), cos, sin).reshape(B, S, H, 2, dh)
    f32 = jnp.float32
    lam = (jnp.exp(jnp.sum(lam_q1.astype(f32) * lam_k1.astype(f32)))
           - jnp.exp(jnp.sum(lam_q2.astype(f32) * lam_k2.astype(f32))) + lambda_init)
    nb = S // Q_BLOCK
    qb = jnp.transpose(q.reshape(B, nb, Q_BLOCK, H, 2, dh), (1, 0, 2, 3, 4, 5))
    scale = dh ** -0.5

    def one_block(qblk):
        s = jnp.einsum('bqhtd,bkhtd->bhtqk', qblk, k).astype(f32) * scale
        p = jax.nn.softmax(s, axis=-1)
        a = p[:, :, 0] - lam * p[:, :, 1]
        return jnp.einsum('bhqk,bkhe->bqhe', a.astype(v.dtype), v)

    o = lax.map(one_block, qb)
    o = jnp.transpose(o, (1, 0, 2, 3, 4)).reshape(B, S, H, 2 * dh)
    o = rms_norm(o, subln_g) * (1.0 - lambda_init)
    return o.reshape(B, S, H * 2 * dh)


def memory_cross_attention(h, mem_n, wq, wk, wv, wo):
    B, S, _ = h.shape
    M = mem_n.shape[1]
    q = (h @ wq).reshape(B, S, MEM_HEADS, HEAD_DIM)
    k = (mem_n @ wk).reshape(B, M, MEM_HEADS, HEAD_DIM)
    v = (mem_n @ wv).reshape(B, M, MEM_HEADS, HEAD_DIM)
    s = jnp.einsum('bshd,bmhd->bhsm', q, k).astype(jnp.float32) * (HEAD_DIM ** -0.5)
    p = jax.nn.softmax(s, axis=-1).astype(v.dtype)
    o = jnp.einsum('bhsm,bmhd->bshd', p, v).reshape(B, S, MEM_W)
    return o @ wo


def squared_relu_mlp(h, w_up, w_down):
    u = jax.nn.relu(h @ w_up)
    return (u * u) @ w_down


def setup_inputs(seed: int = 0) -> dict:
    key = jax.random.key(seed)
    ks = jax.random.split(key, 32)
    f32 = jnp.float32

    def w(k, shape, fan_in):
        return jax.random.normal(k, shape, f32) * fan_in ** -0.5

    def gain(k, shape):
        return 1.0 + 0.05 * jax.random.normal(k, shape, f32)

    return {
        "x": jax.random.normal(ks[0], (BATCH, SEQ, D_MODEL), f32),
        "mem": jax.random.normal(ks[1], (BATCH, MEM_LEN, D_MODEL), f32),
        "even_w_in": w(ks[2], (N_EVEN, D_MODEL, EVEN_IN), D_MODEL),
        "even_w_out": w(ks[3], (N_EVEN, EVEN_OUT, D_MODEL), EVEN_OUT),
        "na_rpb": 0.5 * jax.random.normal(ks[4], (N_EVEN, NA_HEADS, 2 * NA_KH_MAX - 1, 2 * NA_KW - 1), f32),
        "sw_sinks": jax.random.normal(ks[5], (N_EVEN, SW_Q_HEADS), f32),
        "odd_w_in": w(ks[6], (N_ODD, D_MODEL, ODD_IN), D_MODEL),
        "odd_w_out": w(ks[7], (N_ODD, DIFF_W, D_MODEL), DIFF_W),
        "diff_lam_q1": 0.1 * jax.random.normal(ks[8], (N_ODD, HEAD_DIM), f32),
        "diff_lam_k1": 0.1 * jax.random.normal(ks[9], (N_ODD, HEAD_DIM), f32),
        "diff_lam_q2": 0.1 * jax.random.normal(ks[10], (N_ODD, HEAD_DIM), f32),
        "diff_lam_k2": 0.1 * jax.random.normal(ks[11], (N_ODD, HEAD_DIM), f32),
        "diff_subln_g": gain(ks[12], (N_ODD, 2 * HEAD_DIM)),
        "mix_pre_g": gain(ks[13], (DEPTH, D_MODEL)),
        "mix_post_g": gain(ks[14], (DEPTH, D_MODEL)),
        "mem_norm_g": gain(ks[15], (DEPTH, D_MODEL)),
        "mem_pre_g": gain(ks[16], (DEPTH, D_MODEL)),
        "mem_post_g": gain(ks[17], (DEPTH, D_MODEL)),
        "mem_wq": w(ks[18], (DEPTH, D_MODEL, MEM_W), D_MODEL),
        "mem_wk": w(ks[19], (DEPTH, D_MODEL, MEM_W), D_MODEL),
        "mem_wv": w(ks[20], (DEPTH, D_MODEL, MEM_W), D_MODEL),
        "mem_wo": w(ks[21], (DEPTH, MEM_W, D_MODEL), MEM_W),
        "mlp_pre_g": gain(ks[22], (DEPTH, D_MODEL)),
        "mlp_post_g": gain(ks[23], (DEPTH, D_MODEL)),
        "mlp_w_up": w(ks[24], (DEPTH, D_MODEL, D_FF), D_MODEL),
        "mlp_w_down": w(ks[25], (DEPTH, D_FF, D_MODEL), D_FF),
    }


def reference(x, mem, even_w_in, even_w_out, na_rpb, sw_sinks, odd_w_in, odd_w_out,
              diff_lam_q1, diff_lam_k1, diff_lam_q2, diff_lam_k2, diff_subln_g,
              mix_pre_g, mix_post_g, mem_norm_g, mem_pre_g, mem_post_g,
              mem_wq, mem_wk, mem_wv, mem_wo, mlp_pre_g, mlp_post_g, mlp_w_up, mlp_w_down):
    B, S, D = x.shape
    cos, sin = rope_tables(S)
    h = x
    for layer in range(DEPTH):
        hn = rms_norm(h, mix_pre_g[layer])
        if layer % 2 == 0:
            e = layer // 2
            proj = hn @ even_w_in[e]
            o0 = 0
            qa = proj[..., o0:o0 + NA_W]; o0 += NA_W
            ka = proj[..., o0:o0 + NA_W]; o0 += NA_W
            va = proj[..., o0:o0 + NA_W]; o0 += NA_W
            qs = proj[..., o0:o0 + SW_QW]; o0 += SW_QW
            kss = proj[..., o0:o0 + SW_KVW]; o0 += SW_KVW
            vs = proj[..., o0:o0 + SW_KVW]
            out_a = neighbourhood_attention(
                qa.reshape(B, S, NA_HEADS, HEAD_DIM), ka.reshape(B, S, NA_HEADS, HEAD_DIM),
                va.reshape(B, S, NA_HEADS, HEAD_DIM), na_rpb[e])
            out_b = sliding_window_gqa(
                qs.reshape(B, S, SW_Q_HEADS, HEAD_DIM), kss.reshape(B, S, SW_KV_HEADS, HEAD_DIM),
                vs.reshape(B, S, SW_KV_HEADS, HEAD_DIM), sw_sinks[e], cos, sin)
            y = jnp.concatenate([out_a.reshape(B, S, NA_W), out_b.reshape(B, S, SW_QW)], axis=-1)
            y = y @ even_w_out[e]
        else:
            o = layer // 2
            proj = hn @ odd_w_in[o]
            qd = proj[..., :DIFF_W].reshape(B, S, DIFF_HEADS, 2, HEAD_DIM)
            kd = proj[..., DIFF_W:2 * DIFF_W].reshape(B, S, DIFF_HEADS, 2, HEAD_DIM)
            vd = proj[..., 2 * DIFF_W:].reshape(B, S, DIFF_HEADS, 2 * HEAD_DIM)
            lambda_init = 0.8 - 0.6 * math.exp(-0.3 * layer)
            y = differential_attention(qd, kd, vd, diff_lam_q1[o], diff_lam_k1[o],
                                       diff_lam_q2[o], diff_lam_k2[o], diff_subln_g[o],
                                       lambda_init, cos, sin)
            y = y @ odd_w_out[o]
        h = h + rms_norm(y, mix_post_g[layer])
        mem_n = rms_norm(mem, mem_norm_g[layer])
        c = memory_cross_attention(rms_norm(h, mem_pre_g[layer]), mem_n, mem_wq[layer],
                                   mem_wk[layer], mem_wv[layer], mem_wo[layer])
        h = h + rms_norm(c, mem_post_g[layer])
        f = squared_relu_mlp(rms_norm(h, mlp_pre_g[layer]), mlp_w_up[layer], mlp_w_down[layer])
        h = h + rms_norm(f, mlp_post_g[layer])
    return h
```

```cpp
#include <hip/hip_runtime.h>
#include <hip/hip_cooperative_groups.h>
#include <cstdio>
#include <cstdint>
namespace cg = cooperative_groups;
__device__ __forceinline__ int opaque_tid(int wv) { int t; asm volatile("v_mbcnt_lo_u32_b32 %0, -1, 0\n\tv_mbcnt_hi_u32_b32 %0, -1, %0\n\tv_lshl_add_u32 %0, %1, 6, %0" : "=&v"(t) : "s"(wv)); return t; }

namespace pg8 {
#define PG8_LAS __attribute__((address_space(3)))
typedef unsigned short bf16_t;
typedef short bf16x8 __attribute__((ext_vector_type(8)));
typedef float f32x4 __attribute__((ext_vector_type(4)));
typedef unsigned u32x4 __attribute__((ext_vector_type(4)));
constexpr int BM = 256, BK = 64, HALF = 128, HTB = HALF * BK * 2  , STAGE_BYTES = 8 * HTB, NXCD = 8, WGM = 8;

__host__ __device__ __forceinline__ int lds_byte(int r, int c) { const int st = (r >> 4) * 2 + (c >> 5), rr = r & 15, cc = c & 31, ob = rr * 64 + cc * 2; return st * 1024 + (ob ^ (((ob >> 9) & 1) << 5)); }
__host__ __device__ __forceinline__ void stage_rc(int b, int& R, int& C) { const int st = b / 1024, sb = b % 1024, swz = sb ^ (((sb >> 9) & 1) << 5); R = (st >> 1) * 16 + swz / 64; C = (st & 1) * 32 + (swz % 64) / 2; }
__host__ __device__ __forceinline__ int perm32(int rho) { const int n = rho >> 4, i = rho & 15; return 8 * (i >> 2) + 4 * n + (i & 3); }

struct Unit { int pm, pn; };
struct Gemm { const bf16_t* A; const bf16_t* Bt; int M, N, K; };

struct StaticOrder {
    int nM, nN, nwg, G, c;
    __host__ __device__ void init(int M, int N, int G_, int c_) { nM = M / BM; nN = N / BM; nwg = nM * nN; G = G_; c = c_; }
    __host__ __device__ bool next(int i, Unit& u) const {
        const long L = (long)i * G + c; if (L >= nwg) return false;
        int wgid = (int)L; { const int q = nwg / NXCD, r = nwg % NXCD, xcd = wgid % NXCD, off = wgid / NXCD; wgid = (xcd < r ? xcd * (q + 1) : r * (q + 1) + (xcd - r) * q) + off; }
        const int nig = WGM * nN, gid = wgid / nig, fm = gid * WGM, gsz = (nM - fm) < WGM ? (nM - fm) : WGM;
        u.pm = fm + ((wgid % nig) % gsz); u.pn = (wgid % nig) / gsz; return true;
    }
    __device__ __forceinline__ void a_ready(const Unit&) const {}
    __device__ __forceinline__ void done(const Unit&) const {}
};

__device__ __forceinline__ unsigned cvt_pk_bf16(float lo, float hi) { unsigned r; asm volatile("v_cvt_pk_bf16_f32 %0, %1, %2" : "=v"(r) : "v"(lo), "v"(hi)); return r; }
struct EpiF32 {
    static constexpr int ID = 2; static constexpr bool PERM = false, AFTER_DRAIN = false;
    float* C; int ldc;
    __device__ __forceinline__ void operator()(const f32x4 (&acc)[2][2][4][2], const Unit& u, int wr, int wc, int fr, int fq) const {
        const int row0 = u.pm * BM + wr * 64 + fr, col0 = u.pn * BM + wc * 32 + 4 * fq;
#pragma unroll
        for (int ai = 0; ai < 2; ++ai)
#pragma unroll
            for (int m = 0; m < 4; ++m) { float* rowp = C + (size_t)(row0 + ai * HALF + m * 16) * ldc + col0;
#pragma unroll
                for (int bj = 0; bj < 2; ++bj)
#pragma unroll
                    for (int n = 0; n < 2; ++n) *(f32x4*)(rowp + bj * HALF + n * 16) = acc[ai][bj][m][n]; }
    }
    __device__ __forceinline__ void fused(f32x4 (&)[2][2][4][2], const Unit&, int, int, int, int, PG8_LAS unsigned char*, int, int) const {}
};
template <int ACT  > struct EpiBf16 {
    static constexpr int ID = ACT; static constexpr bool PERM = true, AFTER_DRAIN = false;
    bf16_t* O; int ldc;
    __device__ __forceinline__ void operator()(const f32x4 (&acc)[2][2][4][2], const Unit& u, int wr, int wc, int fr, int fq) const {
        const int row0 = u.pm * BM + wr * 64 + fr; const int col0 = u.pn * BM + wc * 32 + 8 * fq;
#pragma unroll
        for (int ai = 0; ai < 2; ++ai)
#pragma unroll
            for (int m = 0; m < 4; ++m) { bf16_t* rowp = O + (size_t)(row0 + ai * HALF + m * 16) * ldc + col0;
#pragma unroll
                for (int bj = 0; bj < 2; ++bj) { f32x4 v0 = acc[ai][bj][m][0], v1 = acc[ai][bj][m][1];
                    if (ACT == 1) {
#pragma unroll
                        for (int j = 0; j < 4; ++j) { const float a = fmaxf(v0[j], 0.f), b = fmaxf(v1[j], 0.f); v0[j] = a * a; v1[j] = b * b; } }
                    u32x4 w; w.x = cvt_pk_bf16(v0[0], v0[1]); w.y = cvt_pk_bf16(v0[2], v0[3]); w.z = cvt_pk_bf16(v1[0], v1[1]); w.w = cvt_pk_bf16(v1[2], v1[3]);
                    *(u32x4*)(rowp + bj * HALF) = w; } }
    }
    __device__ __forceinline__ void fused(f32x4 (&)[2][2][4][2], const Unit&, int, int, int, int, PG8_LAS unsigned char*, int, int) const {}
};

struct EpiBf16Rope {
    static constexpr int ID = 0; static constexpr bool PERM = true, AFTER_DRAIN = false;
    bf16_t* O; int ldc; const float* rope; int head_lo, head_hi;
    __device__ __forceinline__ static float rot(float x, float c, float s, int hi) {
        auto rr = __builtin_amdgcn_permlane32_swap(__float_as_uint(x), __float_as_uint(x), false, false);
        const float y = __uint_as_float(hi ? rr[0] : rr[1]);
        return x * c + y * (hi ? s : -s);
    }
    __device__ __forceinline__ void operator()(const f32x4 (&acc)[2][2][4][2], const Unit& u, int wr, int wc, int fr, int fq) const {
        const int row0 = u.pm * BM + wr * 64 + fr; const int col0 = u.pn * BM + wc * 32 + 8 * fq;
        const int h0 = 2 * u.pn, h1 = h0 + 1, hi = fq >> 1;
        const bool r0 = (wc == 0) && h0 >= head_lo && h0 < head_hi, r1 = (wc == 0) && h1 >= head_lo && h1 < head_hi;
#pragma unroll
        for (int ai = 0; ai < 2; ++ai)
#pragma unroll
            for (int m = 0; m < 4; ++m) { const int row = row0 + ai * HALF + m * 16; bf16_t* rowp = O + (size_t)row * ldc + col0;
                const f32x4* tp = (const f32x4*)(rope + ((size_t)row * 16 + 8 * (fq & 1)) * 2);
#pragma unroll
                for (int bj = 0; bj < 2; ++bj) { f32x4 v0 = acc[ai][bj][m][0], v1 = acc[ai][bj][m][1];
                    if (bj == 0 ? r0 : r1) {
                        { const f32x4 t0 = tp[0], t1 = tp[1];
                          v0[0] = rot(v0[0], t0[0], t0[1], hi); v0[1] = rot(v0[1], t0[2], t0[3], hi); v0[2] = rot(v0[2], t1[0], t1[1], hi); v0[3] = rot(v0[3], t1[2], t1[3], hi); }
                        { const f32x4 t2 = tp[2], t3 = tp[3];
                          v1[0] = rot(v1[0], t2[0], t2[1], hi); v1[1] = rot(v1[1], t2[2], t2[3], hi); v1[2] = rot(v1[2], t3[0], t3[1], hi); v1[3] = rot(v1[3], t3[2], t3[3], hi); } }
                    u32x4 w; w.x = cvt_pk_bf16(v0[0], v0[1]); w.y = cvt_pk_bf16(v0[2], v0[3]); w.z = cvt_pk_bf16(v1[0], v1[1]); w.w = cvt_pk_bf16(v1[2], v1[3]);
                    *(u32x4*)(rowp + bj * HALF) = w; } }
    }
};

template <class Epi, class Sched, bool ALIGN_EPI = false, bool SP2 = false>
__device__ __forceinline__ void gemm_phase(PG8_LAS unsigned char* lds, const Gemm g, const Sched& S, const Epi& E, int wv) {
    const int tid = opaque_tid(wv), wid = __builtin_amdgcn_readfirstlane(tid >> 6), lane = tid & 63, wr = wid >> 2, wc = wid & 3, fr = lane & 15, fq = lane >> 4;
    const int K = g.K, nt = K / BK;
    unsigned voffA[2], voffB[2];
#pragma unroll
    for (int i = 0; i < 2; ++i) { int R, C; stage_rc(tid * 16 + i * 8192, R, C); const int Rb = Epi::PERM ? ((R & ~31) + perm32(R & 31)) : R;
        voffA[i] = (unsigned)(R * K + C) * 2u; voffB[i] = (unsigned)(Rb * K + C) * 2u; }
    const size_t kstep = (size_t)(BK * 2);
    const size_t hstep = (size_t)HALF * K * 2;
    const size_t tstep = 2 * hstep;
    const unsigned ldsw = (unsigned)wid * 1024u;
    const int aoff = lds_byte(wr * 64 + fr, fq * 8), boff = lds_byte(wc * 32 + fr, fq * 8);
#define PG8_SA(b, h) (((b) * 2 + (h)) * HTB)
#define PG8_SB(b, h) ((4 + (b) * 2 + (h)) * HTB)
#define PG8_STAGE(bufoff, gbase, voff) do { _Pragma("unroll") for (int _i = 0; _i < 2; ++_i) \
        __builtin_amdgcn_global_load_lds((const unsigned*)((const char*)(gbase) + (voff)[_i]), (PG8_LAS unsigned*)(lds + (bufoff) + ldsw + _i * 8192), 16, 0, 0); } while (0)
#define PG8_LDA(dst, b, h) do { _Pragma("unroll") for (int m = 0; m < 4; ++m) _Pragma("unroll") for (int k = 0; k < 2; ++k) dst[m][k] = *(const PG8_LAS bf16x8*)(lds + PG8_SA(b, h) + aoff + m * 2048 + k * 1024); } while (0)
#define PG8_LDB(dst, b, h) do { _Pragma("unroll") for (int n = 0; n < 2; ++n) _Pragma("unroll") for (int k = 0; k < 2; ++k) dst[n][k] = *(const PG8_LAS bf16x8*)(lds + PG8_SB(b, h) + boff + n * 2048 + k * 1024); } while (0)
#define PG8_MMA(ai, bj, At, Bt) do { __builtin_amdgcn_s_setprio(1); _Pragma("unroll") for (int m = 0; m < 4; ++m) _Pragma("unroll") for (int n = 0; n < 2; ++n) _Pragma("unroll") for (int k = 0; k < 2; ++k) \
        acc[ai][bj][m][n] = __builtin_amdgcn_mfma_f32_16x16x32_bf16(Bt[n][k], At[m][k], acc[ai][bj][m][n], 0, 0, 0); __builtin_amdgcn_s_setprio(0); } while (0)
#define PG8_WAIT_V(n) asm volatile("s_waitcnt vmcnt(" #n ")" ::: "memory")
#define PG8_WAIT_L(n) asm volatile("s_waitcnt lgkmcnt(" #n ")" ::: "memory")
#define PG8_BAR __builtin_amdgcn_s_barrier()
#define PG8_SCHED __builtin_amdgcn_sched_barrier(0)
    Unit cur, nxt; int ui = 0;
    if (!S.next(0, cur)) return;
    f32x4 acc[2][2][4][2];
#pragma unroll
    for (int a = 0; a < 2; ++a)
#pragma unroll
        for (int b = 0; b < 2; ++b)
#pragma unroll
            for (int m = 0; m < 4; ++m)
#pragma unroll
                for (int n = 0; n < 2; ++n) acc[a][b][m][n] = (f32x4){0.f, 0.f, 0.f, 0.f};
    bf16x8 At[4][2], B0[2][2], B1[2][2];
    const char* cA = (const char*)g.A + (size_t)cur.pm * tstep; const char* cB = (const char*)g.Bt + (size_t)cur.pn * tstep;
    S.a_ready(cur);
    if constexpr (SP2) {
        PG8_STAGE(PG8_SB(0, 0), cB, voffB); PG8_STAGE(PG8_SB(0, 1), cB + hstep, voffB); PG8_STAGE(PG8_SA(0, 0), cA, voffA); PG8_STAGE(PG8_SA(0, 1), cA + hstep, voffA);
        if (wr == 1) PG8_BAR;
        PG8_WAIT_V(2); PG8_BAR;
        PG8_STAGE(PG8_SB(1, 0), cB + kstep, voffB); PG8_STAGE(PG8_SA(1, 0), cA + kstep, voffA); PG8_STAGE(PG8_SB(1, 1), cB + hstep + kstep, voffB);
        PG8_WAIT_V(6); PG8_BAR;
    } else {
        PG8_STAGE(PG8_SB(0, 0), cB, voffB); PG8_STAGE(PG8_SA(0, 0), cA, voffA); PG8_STAGE(PG8_SB(0, 1), cB + hstep, voffB); PG8_STAGE(PG8_SA(0, 1), cA + hstep, voffA);
        if (wr == 1) PG8_BAR;
        PG8_WAIT_V(4); PG8_BAR;
        PG8_STAGE(PG8_SB(1, 0), cB + kstep, voffB); PG8_STAGE(PG8_SA(1, 0), cA + kstep, voffA); PG8_STAGE(PG8_SB(1, 1), cB + hstep + kstep, voffB);
        PG8_WAIT_V(6); PG8_BAR;
    }
    for (;;) {
        const bool has_next = S.next(ui + 1, nxt);
        const char* nA = has_next ? (const char*)g.A + (size_t)nxt.pm * tstep : cA; const char* nB = has_next ? (const char*)g.Bt + (size_t)nxt.pn * tstep : cB;
        for (int t = 0; t < nt; t += 2) {
            const bool last = (t == nt - 2);
            const char* a1 = cA + (size_t)(t + 1) * kstep;
            const char* a2 = last ? nA : cA + (size_t)(t + 2) * kstep; const char* b2 = last ? nB : cB + (size_t)(t + 2) * kstep;
            const char* a3 = a2 + kstep; const char* b3 = b2 + kstep;
            if (last && has_next) S.a_ready(nxt);
            if constexpr (SP2) {
            PG8_LDB(B0, 0, 0); PG8_LDB(B1, 0, 1); PG8_SCHED; PG8_LDA(At, 0, 0); PG8_STAGE(PG8_SA(1, 1), a1 + hstep, voffA);
            PG8_WAIT_V(8); PG8_WAIT_L(0); PG8_BAR; PG8_MMA(0, 0, At, B0); PG8_MMA(0, 1, At, B1); PG8_BAR; PG8_SCHED;
            PG8_LDA(At, 0, 1); PG8_STAGE(PG8_SB(0, 0), b2, voffB); PG8_STAGE(PG8_SB(0, 1), b2 + hstep, voffB); PG8_STAGE(PG8_SA(0, 0), a2, voffA);
            PG8_WAIT_V(8); PG8_WAIT_L(0); PG8_BAR; PG8_MMA(1, 0, At, B0); PG8_MMA(1, 1, At, B1); PG8_BAR; PG8_SCHED;
            PG8_LDB(B0, 1, 0); PG8_LDB(B1, 1, 1); PG8_SCHED; PG8_LDA(At, 1, 0); PG8_STAGE(PG8_SA(0, 1), a2 + hstep, voffA);
            PG8_WAIT_V(8); PG8_WAIT_L(0); PG8_BAR; PG8_MMA(0, 0, At, B0); PG8_MMA(0, 1, At, B1); PG8_BAR; PG8_SCHED;
            PG8_LDA(At, 1, 1); PG8_STAGE(PG8_SB(1, 0), b3, voffB); PG8_STAGE(PG8_SB(1, 1), b3 + hstep, voffB); PG8_STAGE(PG8_SA(1, 0), a3, voffA);
            PG8_WAIT_V(8); PG8_WAIT_L(0); PG8_BAR; PG8_MMA(1, 0, At, B0); PG8_MMA(1, 1, At, B1); PG8_BAR; PG8_SCHED;
            } else {
            PG8_LDB(B0, 0, 0); PG8_SCHED; PG8_LDA(At, 0, 0); PG8_STAGE(PG8_SA(1, 1), a1 + hstep, voffA);
            PG8_WAIT_L(8); PG8_BAR; PG8_WAIT_L(0); PG8_MMA(0, 0, At, B0); PG8_BAR; PG8_SCHED;
            PG8_LDB(B1, 0, 1); PG8_STAGE(PG8_SB(0, 0), b2, voffB);
            PG8_BAR; PG8_WAIT_L(0); PG8_MMA(0, 1, At, B1); PG8_BAR;
            PG8_LDA(At, 0, 1); PG8_STAGE(PG8_SA(0, 0), a2, voffA);
            PG8_BAR; PG8_WAIT_L(0); PG8_MMA(1, 0, At, B0); PG8_BAR; PG8_SCHED;
            PG8_STAGE(PG8_SB(0, 1), b2 + hstep, voffB);
            PG8_WAIT_V(6); PG8_BAR; PG8_MMA(1, 1, At, B1); PG8_BAR;
            PG8_LDB(B0, 1, 0); PG8_SCHED; PG8_LDA(At, 1, 0); PG8_STAGE(PG8_SA(0, 1), a2 + hstep, voffA);
            PG8_WAIT_L(8); PG8_BAR; PG8_WAIT_L(0); PG8_MMA(0, 0, At, B0); PG8_BAR; PG8_SCHED;
            PG8_LDB(B1, 1, 1); PG8_STAGE(PG8_SB(1, 0), b3, voffB);
            PG8_BAR; PG8_WAIT_L(0); PG8_MMA(0, 1, At, B1); PG8_BAR;
            PG8_LDA(At, 1, 1); PG8_STAGE(PG8_SA(1, 0), a3, voffA);
            PG8_BAR; PG8_WAIT_L(0); PG8_MMA(1, 0, At, B0); PG8_BAR; PG8_SCHED;
            PG8_STAGE(PG8_SB(1, 1), b3 + hstep, voffB);
            PG8_WAIT_V(6); PG8_BAR; PG8_MMA(1, 1, At, B1); PG8_BAR;
            }
        }
        if constexpr (ALIGN_EPI) { if (wr == 0) PG8_BAR; }
        if constexpr (!Epi::AFTER_DRAIN) { E(acc, cur, wr, wc, fr, fq); S.done(cur); }
        if (!has_next) break;
#pragma unroll
        for (int a = 0; a < 2; ++a)
#pragma unroll
            for (int b = 0; b < 2; ++b)
#pragma unroll
                for (int m = 0; m < 4; ++m)
#pragma unroll
                    for (int n = 0; n < 2; ++n) acc[a][b][m][n] = (f32x4){0.f, 0.f, 0.f, 0.f};
        cur = nxt; cA = nA; cB = nB; ++ui;
        if constexpr (ALIGN_EPI) { if (wr == 1) PG8_BAR; }
    }
    PG8_WAIT_V(0);
    if constexpr (!ALIGN_EPI) { if (wr == 0) PG8_BAR; }
    PG8_BAR;
    if constexpr (Epi::AFTER_DRAIN) { E.fused(acc, cur, wr, wc, fr, fq, lds, wid, lane); S.done(cur); }
#undef PG8_SA
#undef PG8_SB
#undef PG8_STAGE
#undef PG8_LDA
#undef PG8_LDB
#undef PG8_MMA
#undef PG8_WAIT_V
#undef PG8_WAIT_L
#undef PG8_BAR
#undef PG8_SCHED
}
}
namespace att {
typedef unsigned short u16;
constexpr int   D = 128, NW = 8, QBLK = 32, KVBLK = 64;
constexpr float SCALE = 0.088388347648318440f;
constexpr float THR = 8.f;
constexpr size_t SHM_V = KVBLK * D * 2, SHM_K = KVBLK * D * 2, SHM_ATTN = 2 * SHM_V + 2 * SHM_K + NW * 64 * 4;
using bf16x8 = __attribute__((ext_vector_type(8))) short;
using s16x4  = __attribute__((ext_vector_type(4))) short;
using f32x16 = __attribute__((ext_vector_type(16))) float;
using u32x4  = __attribute__((ext_vector_type(4))) unsigned;
#define KSWZ(row, colB) ((row) * 256 + ((colB) ^ (((row) & 7) << 4)))
#define SBAR() __builtin_amdgcn_sched_barrier(0)
__device__ __forceinline__ int crow(int r, int hi) { return (r & 3) + 8 * (r >> 2) + 4 * hi; }
__device__ __forceinline__ unsigned cvtpk(float lo, float hi) {
  unsigned r; asm volatile("v_cvt_pk_bf16_f32 %0, %1, %2" : "=v"(r) : "v"(lo), "v"(hi)); return r;
}
__device__ __forceinline__ bf16x8 ld8(const u16* p) { return *reinterpret_cast<const bf16x8*>(p); }

__device__ __forceinline__ void partialSM(f32x16& p0, f32x16& p1, float& m_reg, float& mn, float& alpha) {
  constexpr float C = SCALE * 1.4426950408889634f;
  float pmax = p0[0]; for (int r = 1; r < 16; ++r) pmax = fmaxf(pmax, p0[r]); for (int r = 0; r < 16; ++r) pmax = fmaxf(pmax, p1[r]);
  { auto rr = __builtin_amdgcn_permlane32_swap(__float_as_uint(pmax), __float_as_uint(pmax), false, false);
    pmax = fmaxf(__uint_as_float(rr[0]), __uint_as_float(rr[1])); }
  if (__builtin_expect(__all(pmax - m_reg <= THR / SCALE), 1)) { mn = m_reg; alpha = 1.f; }
  else { mn = fmaxf(m_reg, pmax); alpha = __builtin_amdgcn_exp2f((m_reg - mn) * C); m_reg = mn; }
  float mnC = -mn * C;
  for (int r = 0; r < 16; ++r) p0[r] = fmaf(p0[r], C, mnC); for (int r = 0; r < 16; ++r) p1[r] = fmaf(p1[r], C, mnC);
  for (int r = 0; r < 16; ++r) p0[r] = __builtin_amdgcn_exp2f(p0[r]);
}
__device__ __forceinline__ void finishSM(f32x16& p0, f32x16& p1, float alpha, float& l_reg, bf16x8& pa0, bf16x8& pa1, bf16x8& pa2, bf16x8& pa3) {
  for (int r = 0; r < 16; ++r) p1[r] = __builtin_amdgcn_exp2f(p1[r]);
  float ps = 0; for (int r = 0; r < 16; ++r) ps += p0[r]; for (int r = 0; r < 16; ++r) ps += p1[r];
  { auto rr = __builtin_amdgcn_permlane32_swap(__float_as_uint(ps), __float_as_uint(ps), false, false);
    ps = __uint_as_float(rr[0]) + __uint_as_float(rr[1]); }
  l_reg = l_reg * alpha + ps;
#define PK4(P, BASE, OUT) do { unsigned a0 = cvtpk(P[BASE + 0], P[BASE + 1]), a1 = cvtpk(P[BASE + 2], P[BASE + 3]);   \
    unsigned b0 = cvtpk(P[BASE + 4], P[BASE + 5]), b1 = cvtpk(P[BASE + 6], P[BASE + 7]);                              \
    auto r0 = __builtin_amdgcn_permlane32_swap(a0, b0, false, false); auto r1 = __builtin_amdgcn_permlane32_swap(a1, b1, false, false); \
    u32x4 w = {r0[0], r1[0], r0[1], r1[1]}; OUT = *reinterpret_cast<bf16x8*>(&w); } while (0)
  PK4(p0, 0, pa0); PK4(p0, 8, pa1); PK4(p1, 0, pa2); PK4(p1, 8, pa3);
#undef PK4
}
__device__ __forceinline__ void qkt(f32x16& p0, f32x16& p1, const char* Ks, const bf16x8* qr, int r32, int hi) {
  p0 = f32x16{}; p1 = f32x16{};
  for (int d0 = 0; d0 < 8; ++d0) { int cb = (d0 * 16 + hi * 8) * 2;
    bf16x8 b0 = *reinterpret_cast<const bf16x8*>(Ks + KSWZ(r32, cb));
    bf16x8 b1 = *reinterpret_cast<const bf16x8*>(Ks + KSWZ(32 + r32, cb));
    p0 = __builtin_amdgcn_mfma_f32_32x32x16_bf16(b0, qr[d0], p0, 0, 0, 0);
    p1 = __builtin_amdgcn_mfma_f32_32x32x16_bf16(b1, qr[d0], p1, 0, 0, 0); }
}
__device__ __forceinline__ int v_st(int k, int c) { const int kk = (k & ~0xC) | ((k & 4) << 1) | ((k & 8) >> 1); return ((kk >> 3) * 4 + (c >> 5)) * 512 + ((kk & 7) * 32 + (c & 31)) * 2; }
__device__ __forceinline__ int v_rd_base(int lane) { return ((lane & 3) << 3) | (((lane >> 2) & 3) << 6) | (((lane >> 4) & 1) << 5) | (((lane >> 5) & 1) << 8); }
constexpr int v_rd_off(int d0, int ks, int half) { return d0 * 512 + ks * 4096 + half * 2048; }
template <int OFF> __device__ __forceinline__ s16x4 tr_read(int vb) {
  s16x4 r; asm volatile("ds_read_b64_tr_b16 %0, %1 offset:%2" : "=&v"(r) : "v"(vb), "i"(OFF) : "memory"); return r;
}
template <int D0> __device__ __forceinline__ void pv_one(f32x16& od, int vb, bf16x8 pa0, bf16x8 pa1, bf16x8 pa2, bf16x8 pa3) {
  const s16x4 l0 = tr_read<v_rd_off(D0, 0, 0)>(vb), h0 = tr_read<v_rd_off(D0, 0, 1)>(vb), l1 = tr_read<v_rd_off(D0, 1, 0)>(vb), h1 = tr_read<v_rd_off(D0, 1, 1)>(vb);
  const s16x4 l2 = tr_read<v_rd_off(D0, 2, 0)>(vb), h2 = tr_read<v_rd_off(D0, 2, 1)>(vb), l3 = tr_read<v_rd_off(D0, 3, 0)>(vb), h3 = tr_read<v_rd_off(D0, 3, 1)>(vb);
  asm volatile("s_waitcnt lgkmcnt(0)" ::: "memory"); SBAR();
#define PK(L, H) (bf16x8){L[0], L[1], L[2], L[3], H[0], H[1], H[2], H[3]}
  od = __builtin_amdgcn_mfma_f32_32x32x16_bf16(pa0, PK(l0, h0), od, 0, 0, 0);
  od = __builtin_amdgcn_mfma_f32_32x32x16_bf16(pa1, PK(l1, h1), od, 0, 0, 0);
  od = __builtin_amdgcn_mfma_f32_32x32x16_bf16(pa2, PK(l2, h2), od, 0, 0, 0);
  od = __builtin_amdgcn_mfma_f32_32x32x16_bf16(pa3, PK(l3, h3), od, 0, 0, 0);
#undef PK
}
__device__ __forceinline__ void pv_d0(f32x16* o, int vb, bf16x8 pa0, bf16x8 pa1, bf16x8 pa2, bf16x8 pa3) {
  pv_one<0>(o[0], vb, pa0, pa1, pa2, pa3); pv_one<1>(o[1], vb, pa0, pa1, pa2, pa3); pv_one<2>(o[2], vb, pa0, pa1, pa2, pa3); pv_one<3>(o[3], vb, pa0, pa1, pa2, pa3);
}

#define PVR(HB, S) const s16x4 S##l0 = tr_read<v_rd_off((HB) >> 1, 2 * ((HB) & 1), 0)>(vb), S##h0 = tr_read<v_rd_off((HB) >> 1, 2 * ((HB) & 1), 1)>(vb), \
    S##l1 = tr_read<v_rd_off((HB) >> 1, 2 * ((HB) & 1) + 1, 0)>(vb), S##h1 = tr_read<v_rd_off((HB) >> 1, 2 * ((HB) & 1) + 1, 1)>(vb)
#define PVK(L, H) (bf16x8){L[0], L[1], L[2], L[3], H[0], H[1], H[2], H[3]}
#define PVM(HB, S, PA, PB) do { o[(HB) >> 1] = __builtin_amdgcn_mfma_f32_32x32x16_bf16(PA, PVK(S##l0, S##h0), o[(HB) >> 1], 0, 0, 0); \
    o[(HB) >> 1] = __builtin_amdgcn_mfma_f32_32x32x16_bf16(PB, PVK(S##l1, S##h1), o[(HB) >> 1], 0, 0, 0); } while (0)
#define PVW(N) do { asm volatile("s_waitcnt lgkmcnt(" #N ")" ::: "memory"); SBAR(); } while (0)
__device__ __forceinline__ void pv_pipe(f32x16* o, int vb, bf16x8 pa0, bf16x8 pa1, bf16x8 pa2, bf16x8 pa3) {
  PVR(0, a); PVR(1, b); PVR(2, c);
  PVW(8); PVM(0, a, pa0, pa1); PVR(3, d);
  PVW(8); PVM(1, b, pa2, pa3); PVR(4, e);
  PVW(8); PVM(2, c, pa0, pa1); PVR(5, f);
  PVW(8); PVM(3, d, pa2, pa3); PVR(6, g);
  PVW(8); PVM(4, e, pa0, pa1); PVR(7, h);
  PVW(8); PVM(5, f, pa2, pa3);
  PVW(4); PVM(6, g, pa0, pa1);
  PVW(0); PVM(7, h, pa2, pa3);
}
#undef PVR
#undef PVK
#undef PVM
#undef PVW

struct ModNone { __device__ __forceinline__ void operator()(f32x16&, f32x16&, int) const {}
  __device__ __forceinline__ bool active(int) const { return true; } };
struct ModSWA { int qrel, hi, qw  ;
  __device__ __forceinline__ bool active(int t) const { return 64 * t <= qw + 159 && 64 * t + 191 >= qw; }
  __device__ __forceinline__ void operator()(f32x16& p0, f32x16& p1, int t) const {
    const int x = qrel - t * 64 - 4 * hi, lo = x - 128, up = x + 128; const float ninf = -__builtin_inff();
#pragma unroll
    for (int r = 0; r < 16; ++r) { const int kc = (r & 3) + 8 * (r >> 2);
      p0[r] = (lo <= kc && up >= kc) ? p0[r] : ninf; p1[r] = (lo <= kc + 32 && up >= kc + 32) ? p1[r] : ninf; }
  } };
struct ModNA { int kr0, qi, qj, rs, cs, hi; const __attribute__((address_space(3))) float* tab;
  __device__ __forceinline__ bool active(int t) const { const int kr = kr0 + t; return kr >= rs && kr < rs + 8; }
  __device__ __forceinline__ void operator()(f32x16& p0, f32x16& p1, int t) const {
    const int kr = kr0 + t; const float ninf = -__builtin_inff();
    if (kr < rs || kr >= rs + 8) {
#pragma unroll
      for (int r = 0; r < 16; ++r) { p0[r] = ninf; p1[r] = ninf; }
    } else {
      const __attribute__((address_space(3))) float* trow = tab + ((kr - qi + 7) * 31 + 15 - qj + 4 * hi);
      const int c0 = 4 * hi - cs;
#pragma unroll
      for (int r = 0; r < 16; ++r) { const int kc = (r & 3) + 8 * (r >> 2); const int ia = kc + c0, ib = ia + 32;
        const float ba = trow[kc], bb = trow[kc + 32];
        p0[r] = ((unsigned)ia < 16u) ? p0[r] + ba : ninf; p1[r] = ((unsigned)ib < 16u) ? p1[r] + bb : ninf; }
    }
  } };

template <int LDQ, int LDK, int LDO, class Mod>
__device__ __forceinline__ void attn_body(const u16* __restrict__ Qb, const u16* __restrict__ Kh, const u16* __restrict__ Vh,
                                          u16* __restrict__ Ob, int NT, char* lds, int wv, const Mod& mod, float m_init, float l_init) {
  const int tid = opaque_tid(wv), wid = tid >> 6, lane = tid & 63, r32 = lane & 31, hi = lane >> 5;
  char* V_lds = lds; char* K_lds = lds + 2 * SHM_V;
  float* ws = (float*)(lds + 2 * SHM_V + 2 * SHM_K) + wid * 64; float* li_l = ws; float* al_l = ws + 32;
  float m_reg = m_init, l_reg = l_init; f32x16 o[4] = {}; bf16x8 qr[8];
  const u16* Qw = Qb + (long)(wid * QBLK + r32) * LDQ + hi * 8;
#pragma unroll
  for (int d0 = 0; d0 < 8; ++d0) qr[d0] = ld8(Qw + d0 * 16);
  const int sr = tid >> 4, sc = (tid & 15) * 8, vst0 = v_st(sr, sc), vst1 = v_st(32 + sr, sc);
  const int vb0 = (int)(uintptr_t)V_lds + v_rd_base(lane);
  struct { bf16x8 vs0, vs1, ks0, ks1; } sr_[1];
#define SLOAD(i, k0) do { sr_[i].vs0 = ld8(&Vh[(long)((k0) + sr) * LDK + sc]); sr_[i].vs1 = ld8(&Vh[(long)((k0) + 32 + sr) * LDK + sc]); \
    sr_[i].ks0 = ld8(&Kh[(long)((k0) + sr) * LDK + sc]); sr_[i].ks1 = ld8(&Kh[(long)((k0) + 32 + sr) * LDK + sc]); } while (0)
#define SWRITE(b, i) do { *(bf16x8*)(V_lds + (b) * SHM_V + vst0) = sr_[i].vs0;          \
    *(bf16x8*)(V_lds + (b) * SHM_V + vst1) = sr_[i].vs1; int kc = sc * 2;               \
    *(bf16x8*)(K_lds + (b) * SHM_K + KSWZ(sr, kc)) = sr_[i].ks0;                       \
    *(bf16x8*)(K_lds + (b) * SHM_K + KSWZ(32 + sr, kc)) = sr_[i].ks1; } while (0)
#define SWAIT() asm volatile("s_waitcnt vmcnt(0)" ::: "memory")
#define RESC(a) do { if (__any((a) < 1.f)) { if (hi == 0) al_l[r32] = (a); asm volatile("s_waitcnt lgkmcnt(0)" ::: "memory"); \
    for (int d = 0; d < 4; ++d) for (int r = 0; r < 16; ++r) o[d][r] *= al_l[crow(r, hi)]; } } while (0)
  f32x16 pA0, pA1, pB0, pB1; float mnA, mnB, alA, alB; bf16x8 pa0, pa1, pa2, pa3;
  constexpr int SE = 0, SO = 0;
  SLOAD(SE, 0); asm volatile("s_waitcnt vmcnt(0)" ::: "memory"); SWRITE(0, SE); __syncthreads();
  if (mod.active(0)) qkt(pA0, pA1, K_lds, qr, r32, hi); else { pA0 = f32x16{}; pA1 = f32x16{}; }
  mod(pA0, pA1, 0); partialSM(pA0, pA1, m_reg, mnA, alA);
  SLOAD(SO, KVBLK);
  SWAIT(); SWRITE(1, SO); __syncthreads();
  for (int j = 1; j + 1 < NT; j += 2) {
    SBAR(); if (mod.active(j)) qkt(pB0, pB1, K_lds + SHM_K, qr, r32, hi); else { pB0 = f32x16{}; pB1 = f32x16{}; }
    finishSM(pA0, pA1, alA, l_reg, pa0, pa1, pa2, pa3); SBAR();
    SLOAD(SO, (j + 1) * KVBLK); SBAR();
    if (mod.active(j - 1)) pv_pipe(o, vb0, pa0, pa1, pa2, pa3); mod(pB0, pB1, j); partialSM(pB0, pB1, m_reg, mnB, alB);
    __syncthreads(); SWAIT(); SWRITE(0, SE);
    RESC(alB); __syncthreads();
    SBAR(); if (mod.active(j + 1)) qkt(pA0, pA1, K_lds, qr, r32, hi); else { pA0 = f32x16{}; pA1 = f32x16{}; }
    finishSM(pB0, pB1, alB, l_reg, pa0, pa1, pa2, pa3); SBAR();
    SLOAD(SE, (j + 2) * KVBLK); SBAR();
    if (mod.active(j)) pv_pipe(o, vb0 + (int)SHM_V, pa0, pa1, pa2, pa3); mod(pA0, pA1, j + 1); partialSM(pA0, pA1, m_reg, mnA, alA);
    __syncthreads(); SWAIT(); SWRITE(1, SO);
    RESC(alA); __syncthreads();
  }
  SBAR(); if (mod.active(NT - 1)) qkt(pB0, pB1, K_lds + SHM_K, qr, r32, hi); else { pB0 = f32x16{}; pB1 = f32x16{}; }
  finishSM(pA0, pA1, alA, l_reg, pa0, pa1, pa2, pa3); SBAR();
  if (mod.active(NT - 2)) pv_pipe(o, vb0, pa0, pa1, pa2, pa3); mod(pB0, pB1, NT - 1); partialSM(pB0, pB1, m_reg, mnB, alB);
  __syncthreads(); RESC(alB);
  finishSM(pB0, pB1, alB, l_reg, pa0, pa1, pa2, pa3); SBAR();
  if (mod.active(NT - 1)) pv_pipe(o, vb0 + (int)SHM_V, pa0, pa1, pa2, pa3);
  if (hi == 0) li_l[r32] = l_reg; asm volatile("s_waitcnt lgkmcnt(0)" ::: "memory");
  float rli[16];
#pragma unroll
  for (int r = 0; r < 16; ++r) rli[r] = __builtin_amdgcn_rcpf(li_l[crow(r, hi)]);
  u16* Ow = Ob + (long)(wid * QBLK) * LDO;
#pragma unroll
  for (int r = 0; r < 16; ++r) { int orow = crow(r, hi);
#pragma unroll
    for (int d0 = 0; d0 < 4; ++d0) Ow[(long)orow * LDO + d0 * 32 + r32] = (u16)cvtpk(o[d0][r] * rli[r], 0.f); }
  __syncthreads();
#undef SLOAD
#undef SWRITE
#undef SWAIT
#undef RESC
}
__device__ __forceinline__ void qkt_half(f32x16& p, const char* Ks, const bf16x8* qr, int krow, int hi) {
  p = f32x16{};
  for (int d0 = 0; d0 < 8; ++d0) { int cb = (d0 * 16 + hi * 8) * 2;
    bf16x8 b = *reinterpret_cast<const bf16x8*>(Ks + KSWZ(krow, cb));
    p = __builtin_amdgcn_mfma_f32_32x32x16_bf16(b, qr[d0], p, 0, 0, 0); }
}
__device__ __forceinline__ float halfmax(const f32x16& p) {
  float pmax = p[0]; for (int r = 1; r < 16; ++r) pmax = fmaxf(pmax, p[r]);
  auto rr = __builtin_amdgcn_permlane32_swap(__float_as_uint(pmax), __float_as_uint(pmax), false, false);
  return fmaxf(__uint_as_float(rr[0]), __uint_as_float(rr[1]));
}
template <int LDQ, int LDK, int LDV, int LDO>
__device__ __forceinline__ void attn_dv256_body(const u16* __restrict__ Qb, const u16* __restrict__ Kh, const u16* __restrict__ Vh, u16* __restrict__ Ob, int NT, char* lds, int wv) {
  const int tid = opaque_tid(wv), wid = __builtin_amdgcn_readfirstlane(tid >> 6), lane = tid & 63, r32 = lane & 31, hi = lane >> 5;
  const int rg = wid >> 1, ch = wid & 1;
  char* K_lds = lds;
  char* V_lds = lds + 32768;
  char* PX = lds + 98304;
  float* MX = (float*)(lds + 135168);
  float* al_l = (float*)(lds + 139264) + wid * 64;
  float* LX = (float*)(lds + 141312);
  float m_reg = -1e30f, l_reg = 0.f; f32x16 o[4] = {}; bf16x8 qr[8];
  const u16* Qw = Qb + (long)(rg * 32 + r32) * LDQ + hi * 8;
#pragma unroll
  for (int d0 = 0; d0 < 8; ++d0) qr[d0] = ld8(Qw + d0 * 16);
  const int sr = tid >> 4, sc = (tid & 15) * 8, vst0 = v_st(sr, sc), vst1 = v_st(32 + sr, sc), kcb = sc * 2;
  const int vb0 = (int)(uintptr_t)V_lds + ch * 16384 + v_rd_base(lane);
  const int pxw = (wid * 2 * 64 + lane) * 16, px0 = ((wid & ~1) * 2 * 64 + lane) * 16;
  const int krow = 32 * ch + r32;
  bf16x8 ks0, ks1, vs0, vs1, vs2, vs3;
#define KLOAD(k0) do { ks0 = ld8(&Kh[(long)((k0) + sr) * LDK + sc]); ks1 = ld8(&Kh[(long)((k0) + 32 + sr) * LDK + sc]); } while (0)
#define VLOAD(k0) do { vs0 = ld8(&Vh[(long)((k0) + sr) * LDV + sc]); vs1 = ld8(&Vh[(long)((k0) + 32 + sr) * LDV + sc]); \
    vs2 = ld8(&Vh[(long)((k0) + sr) * LDV + 128 + sc]); vs3 = ld8(&Vh[(long)((k0) + 32 + sr) * LDV + 128 + sc]); } while (0)
#define KWRITE(b) do { *(bf16x8*)(K_lds + (b) * 16384 + KSWZ(sr, kcb)) = ks0; *(bf16x8*)(K_lds + (b) * 16384 + KSWZ(32 + sr, kcb)) = ks1; } while (0)
#define VWRITE(b) do { *(bf16x8*)(V_lds + (b) * 32768 + vst0) = vs0; *(bf16x8*)(V_lds + (b) * 32768 + vst1) = vs1; \
    *(bf16x8*)(V_lds + (b) * 32768 + 16384 + vst0) = vs2; *(bf16x8*)(V_lds + (b) * 32768 + 16384 + vst1) = vs3; } while (0)
#define RESC(a) do { if (__any((a) < 1.f)) { if (hi == 0) al_l[r32] = (a); asm volatile("s_waitcnt lgkmcnt(0)" ::: "memory"); \
    for (int d = 0; d < 4; ++d) for (int r = 0; r < 16; ++r) o[d][r] *= al_l[crow(r, hi)]; } } while (0)
#define PK4(P, BASE, OUT) do { unsigned a0 = cvtpk(P[BASE + 0], P[BASE + 1]), a1 = cvtpk(P[BASE + 2], P[BASE + 3]);   \
    unsigned b0 = cvtpk(P[BASE + 4], P[BASE + 5]), b1 = cvtpk(P[BASE + 6], P[BASE + 7]);                              \
    auto r0 = __builtin_amdgcn_permlane32_swap(a0, b0, false, false); auto r1 = __builtin_amdgcn_permlane32_swap(a1, b1, false, false); \
    u32x4 w = {r0[0], r1[0], r0[1], r1[1]}; OUT = *reinterpret_cast<bf16x8*>(&w); } while (0)
  KLOAD(0); asm volatile("s_waitcnt vmcnt(0)" ::: "memory"); KWRITE(0);
  KLOAD(64); asm volatile("s_waitcnt vmcnt(0)" ::: "memory"); KWRITE(1);
  if (2 < NT) KLOAD(128);
  VLOAD(0);
  __syncthreads();
  f32x16 pC, pN; float pmC, pmN = 0.f;
  qkt_half(pC, K_lds, qr, krow, hi);
  pmC = halfmax(pC); MX[(0 * 8 + wid) * 64 + lane] = pmC;
  __syncthreads();
  for (int t = 0; t < NT; ++t) {
    const int par = t & 1;
    if (t + 1 < NT) qkt_half(pN, K_lds + (par ^ 1) * 16384, qr, krow, hi);
    if (t >= 1) {
      const bf16x8 pa0 = *(const bf16x8*)(PX + (par ^ 1) * 16384 + px0), pa1 = *(const bf16x8*)(PX + (par ^ 1) * 16384 + px0 + 1024);
      const bf16x8 pa2 = *(const bf16x8*)(PX + (par ^ 1) * 16384 + px0 + 2048), pa3 = *(const bf16x8*)(PX + (par ^ 1) * 16384 + px0 + 3072);
      pv_pipe(o, vb0 + (par ^ 1) * 32768, pa0, pa1, pa2, pa3);
    }
    float alpha;
    {
      constexpr float C = SCALE * 1.4426950408889634f;
      const float pmP = MX[(par * 8 + (wid ^ 1)) * 64 + lane];
      const float pmax = fmaxf(pmC, pmP);
      float mn;
      if (__builtin_expect(__all(pmax - m_reg <= THR / SCALE), 1)) { mn = m_reg; alpha = 1.f; }
      else { mn = fmaxf(m_reg, pmax); alpha = __builtin_amdgcn_exp2f((m_reg - mn) * C); m_reg = mn; }
      const float mnC = -mn * C;
      for (int r = 0; r < 16; ++r) pC[r] = __builtin_amdgcn_exp2f(fmaf(pC[r], C, mnC));
      float ps = 0; for (int r = 0; r < 16; ++r) ps += pC[r];
      { auto rr = __builtin_amdgcn_permlane32_swap(__float_as_uint(ps), __float_as_uint(ps), false, false);
        ps = __uint_as_float(rr[0]) + __uint_as_float(rr[1]); }
      l_reg = l_reg * alpha + ps;
      bf16x8 fo0, fo1; PK4(pC, 0, fo0); PK4(pC, 8, fo1);
      *(bf16x8*)(PX + par * 16384 + pxw) = fo0; *(bf16x8*)(PX + par * 16384 + pxw + 1024) = fo1;
    }
    RESC(alpha);
    if (t + 1 < NT) { pmN = halfmax(pN); MX[((par ^ 1) * 8 + wid) * 64 + lane] = pmN; }
    asm volatile("s_waitcnt vmcnt(0)" ::: "memory");
    if (t + 2 < NT) KWRITE(par);
    VWRITE(par);
    if (t + 3 < NT) KLOAD((t + 3) * 64);
    if (t + 1 < NT) VLOAD((t + 1) * 64);
    __syncthreads();
    pC = pN; pmC = pmN;
  }
  {
    const int par = (NT - 1) & 1;
    const bf16x8 pa0 = *(const bf16x8*)(PX + par * 16384 + px0), pa1 = *(const bf16x8*)(PX + par * 16384 + px0 + 1024);
    const bf16x8 pa2 = *(const bf16x8*)(PX + par * 16384 + px0 + 2048), pa3 = *(const bf16x8*)(PX + par * 16384 + px0 + 3072);
    pv_pipe(o, vb0 + par * 32768, pa0, pa1, pa2, pa3);
  }
  LX[wid * 64 + lane] = l_reg;
  __syncthreads();
  const float ltot = l_reg + LX[(wid ^ 1) * 64 + lane];
  if (hi == 0) al_l[r32] = ltot; asm volatile("s_waitcnt lgkmcnt(0)" ::: "memory");
  float rli[16];
#pragma unroll
  for (int r = 0; r < 16; ++r) rli[r] = __builtin_amdgcn_rcpf(al_l[crow(r, hi)]);
  u16* Ow = Ob + (long)(rg * 32) * LDO + ch * 128;
#pragma unroll
  for (int r = 0; r < 16; ++r) { int orow = crow(r, hi);
#pragma unroll
    for (int d0 = 0; d0 < 4; ++d0) Ow[(long)orow * LDO + d0 * 32 + r32] = (u16)cvtpk(o[d0][r] * rli[r], 0.f); }
  __syncthreads();
#undef KLOAD
#undef VLOAD
#undef KWRITE
#undef VWRITE
#undef RESC
#undef PK4
}
}

#ifndef PROBE
#define PROBE 0
#endif
#ifndef EN_NA
#define EN_NA 1
#endif
#ifndef EN_SWA
#define EN_SWA 1
#endif
#ifndef EN_DIFF
#define EN_DIFF 1
#endif
#ifndef EN_MEM
#define EN_MEM 1
#endif
#ifndef EN_EPI
#define EN_EPI -1
#endif
#ifndef EN_GEMM
#define EN_GEMM 1
#endif
#define LAS __attribute__((address_space(3)))
typedef unsigned short bf16;
typedef unsigned v4u __attribute__((ext_vector_type(4)));
typedef unsigned v2u __attribute__((ext_vector_type(2)));
typedef float f32x4 __attribute__((ext_vector_type(4)));
constexpr int NWAVES = 8, NTHREADS = 512;
constexpr int S_ = 8192, DM = 2048, MEMLEN = 256, DFF = 8192;
constexpr int EVEN_IN = 4608, ODD_IN = 6144, MEMW = 512;
constexpr float EPS = 1e-6f;
constexpr float LAMBDA_INIT1 = 0.35550906f;
constexpr int LDS_BYTES = 147456;
constexpr int NA_TAB_OFF = 67584 + 512;
constexpr size_t MiB = 1u << 20;
constexpr size_t WS_WIN0 = 0, WS_WOUT0 = 18 * MiB, WS_WIN1 = 26 * MiB, WS_WOUT1 = 50 * MiB, WS_WQ = 58 * MiB  , WS_WKV = 62 * MiB  ,
                 WS_WO = 70 * MiB  , WS_WUP = 74 * MiB  , WS_WDN = 138 * MiB  , WS_MEMN = 202 * MiB, WS_KVM = 204 * MiB,
                 WS_ROPE = 205 * MiB, WS_HN = 206 * MiB, WS_YC = 238 * MiB, WS_Y = 270 * MiB, WS_R1 = 334 * MiB, WS_CTL = 498 * MiB, WS_END = 499 * MiB;
constexpr size_t CTL_ZERO_BYTES = 16384;
constexpr int MISC_OFF = 131072 + 320;
constexpr size_t WS_PROJ = WS_R1, WS_OD = WS_R1 + 96 * MiB, WS_U = WS_R1, WS_QM = WS_R1, WS_OM = WS_R1 + 8 * MiB;

struct Params { const float* in[26]; float* out; unsigned char* ws; };
typedef const __attribute__((address_space(4))) Params* KPtr;
__device__ __forceinline__ KPtr kp() { KPtr p = (KPtr)__builtin_amdgcn_kernarg_segment_ptr(); asm volatile("" : "+s"(p)); return p; }

__device__ __forceinline__ unsigned f2bf(float f) { unsigned u = __builtin_bit_cast(unsigned, f); return (u + 0x7fffu + ((u >> 16) & 1u)) >> 16; }
__device__ __forceinline__ unsigned pk2(float lo, float hi) { return f2bf(lo) | (f2bf(hi) << 16); }
__device__ __forceinline__ float bf_lo(unsigned w) { return __builtin_bit_cast(float, w << 16); }
__device__ __forceinline__ float bf_hi(unsigned w) { return __builtin_bit_cast(float, w & 0xffff0000u); }
__device__ __forceinline__ float wave_sum(float v) {
#pragma unroll
    for (int o = 1; o < 64; o <<= 1) v += __shfl_xor(v, o);
    return v;
}
#define LDS_WAIT() asm volatile("s_waitcnt lgkmcnt(0)" ::: "memory")

__device__ __forceinline__ void transpose_item(const float* __restrict__ W, int K, int N, bf16* __restrict__ WT, int ldk, int row_off, LAS float* scr, int item, int lane) {
    const int nblk = N / 32, kb = item / nblk, nb = item % nblk, k0 = 64 * kb, n0 = 32 * nb;
    float tv[32];
#pragma unroll
    for (int i = 0; i < 32; ++i) { const int kk = 2 * i + (lane >> 5); tv[i] = __builtin_nontemporal_load(&W[(size_t)(k0 + kk) * N + n0 + (lane & 31)]); }
#pragma unroll
    for (int i = 0; i < 32; ++i) { const int kk = 2 * i + (lane >> 5); scr[kk * 33 + (lane & 31)] = tv[i]; }
    LDS_WAIT(); asm volatile("" ::: "memory");
    const int c = lane & 7;
#pragma unroll
    for (int j = 0; j < 4; ++j) { const int n = (lane >> 3) + 8 * j; const LAS float* s = scr + (8 * c) * 33 + n;
        v4u o; o.x = pk2(s[0 * 33], s[1 * 33]); o.y = pk2(s[2 * 33], s[3 * 33]); o.z = pk2(s[4 * 33], s[5 * 33]); o.w = pk2(s[6 * 33], s[7 * 33]);
        *(v4u*)(WT + (size_t)(row_off + n0 + n) * ldk + k0 + 8 * c) = o; }
    LDS_WAIT(); asm volatile("" ::: "memory");
}
__device__ __forceinline__ void transpose_matrix(const float* W, int K, int N, bf16* WT, int row_off, LAS float* scr, int gw, int NGW, int lane, int& base, int ldk = 0) {
    if (ldk == 0) ldk = K;
    const int items = (K / 64) * (N / 32);
    int first = (gw - base) % NGW; if (first < 0) first += NGW;
    for (int it = first; it < items; it += NGW) transpose_item(W, K, N, WT, ldk, row_off, scr, it, lane);
    base = (base + items) % NGW;
}

__device__ __forceinline__ void rms_row_bf16(const float* __restrict__ xrow, const float* __restrict__ g, bf16* __restrict__ orow, int lane) {
    const f32x4* xr = (const f32x4*)xrow + lane; const f32x4* gr = (const f32x4*)g + lane;
    f32x4 v[8]; float s = 0.f;
#pragma unroll
    for (int j = 0; j < 8; ++j) { v[j] = xr[64 * j]; s += (v[j].x * v[j].x + v[j].y * v[j].y) + (v[j].z * v[j].z + v[j].w * v[j].w); }
    const float rinv = 1.f / sqrtf(wave_sum(s) * (1.f / DM) + EPS);
    v2u* o8 = (v2u*)orow + lane;
#pragma unroll
    for (int j = 0; j < 8; ++j) { const f32x4 gg = gr[64 * j]; v2u w; w.x = pk2(v[j].x * rinv * gg.x, v[j].y * rinv * gg.y); w.y = pk2(v[j].z * rinv * gg.z, v[j].w * rinv * gg.w); o8[64 * j] = w; }
}
template <bool HIN_F32, bool HOUT_F32>
__device__ __forceinline__ void resid_row(const void* __restrict__ hin, const bf16* __restrict__ y  , const float* __restrict__ gpost, const float* __restrict__ gpre,
                                          void* __restrict__ hout, bf16* __restrict__ hn, int lane) {
    const v2u* yr = (const v2u*)y + lane; const f32x4* gp = (const f32x4*)gpost + lane;
    f32x4 v[8], hh[8]; float s = 0.f;
#pragma unroll
    for (int j = 0; j < 8; ++j) { const v2u w = yr[64 * j]; v[j] = (f32x4){bf_lo(w.x), bf_hi(w.x), bf_lo(w.y), bf_hi(w.y)}; }
    if constexpr (HIN_F32) { const f32x4* hr = (const f32x4*)hin + lane;
#pragma unroll
        for (int j = 0; j < 8; ++j) hh[j] = hr[64 * j];
    } else { const v2u* hr = (const v2u*)hin + lane;
#pragma unroll
        for (int j = 0; j < 8; ++j) { const v2u w = hr[64 * j]; hh[j] = (f32x4){bf_lo(w.x), bf_hi(w.x), bf_lo(w.y), bf_hi(w.y)}; }
    }
#pragma unroll
    for (int j = 0; j < 8; ++j) s += (v[j].x * v[j].x + v[j].y * v[j].y) + (v[j].z * v[j].z + v[j].w * v[j].w);
    const float rinv = 1.f / sqrtf(wave_sum(s) * (1.f / DM) + EPS);
    float s2 = 0.f;
#pragma unroll
    for (int j = 0; j < 8; ++j) { const f32x4 gg = gp[64 * j];
        v[j] = hh[j] + (v[j] * rinv) * gg;
        if constexpr (HOUT_F32) ((f32x4*)hout + lane)[64 * j] = v[j];
        else { v2u w; w.x = pk2(v[j].x, v[j].y); w.y = pk2(v[j].z, v[j].w); ((v2u*)hout + lane)[64 * j] = w; }
        s2 += (v[j].x * v[j].x + v[j].y * v[j].y) + (v[j].z * v[j].z + v[j].w * v[j].w); }
    if (gpre) {
        const float rinv2 = 1.f / sqrtf(wave_sum(s2) * (1.f / DM) + EPS);
        const f32x4* gq = (const f32x4*)gpre + lane; v2u* o8 = (v2u*)hn + lane;
#pragma unroll
        for (int j = 0; j < 8; ++j) { const f32x4 gg = gq[64 * j]; v2u w; w.x = pk2(v[j].x * rinv2 * gg.x, v[j].y * rinv2 * gg.y); w.y = pk2(v[j].z * rinv2 * gg.z, v[j].w * rinv2 * gg.w); o8[64 * j] = w; }
    }
}

template <class Epi>
__device__ __forceinline__ void run_gemm(PG8_LAS unsigned char* lds, int wv, const bf16* A, const bf16* Bt, int M, int N, int K, const Epi& E, int crot = 0  ) {
    pg8::Gemm g{A, Bt, M, N, K}; pg8::StaticOrder S; S.init(M, N, (int)gridDim.x, (int)((blockIdx.x + gridDim.x - (unsigned)crot) % gridDim.x));
    if (EN_GEMM && (EN_EPI < 0 || EN_EPI == Epi::ID)) pg8::gemm_phase<Epi, pg8::StaticOrder, true, true>(lds, g, S, E, wv);
}
template <bool HIN_F32, bool HOUT_F32>
__device__ __forceinline__ void resid_phase(int wv, const void* hin, const bf16* y, const float* gpost, const float* gpre, void* hout, bf16* hn) {
    const int tid = opaque_tid(wv), lane = tid & 63, gw = blockIdx.x * NWAVES + (tid >> 6), NGW = gridDim.x * NWAVES;
    constexpr size_t SIN = HIN_F32 ? 4 : 2, SOUT = HOUT_F32 ? 4 : 2;
    for (int m = gw; m < S_; m += NGW) resid_row<HIN_F32, HOUT_F32>((const char*)hin + (size_t)m * DM * SIN, y + (size_t)m * DM, gpost, gpre, (char*)hout + (size_t)m * DM * SOUT, hn + (size_t)m * DM, lane);
}
#define XB_TMO      128
#define XB_XCNT(j)  (256  + 64 * (j))
#define XB_XSUB(j)  (1280 + 64 * (j))
#define XB_XGEN(j)  (2304 + 64 * (j))
#define XB_TOP      3328
#define XB_TOPGEN   3392
#define XCD_BAR_WORDS 3456
#define XB_SPIN_CAP (1u << 18)

__device__ __forceinline__ unsigned xb_ld(unsigned* p)              { return __hip_atomic_load(p, __ATOMIC_RELAXED, __HIP_MEMORY_SCOPE_AGENT); }
__device__ __forceinline__ unsigned xb_add(unsigned* p, unsigned v) { return __hip_atomic_fetch_add(p, v, __ATOMIC_RELAXED, __HIP_MEMORY_SCOPE_AGENT); }
__device__ __forceinline__ unsigned xb_xcc_id() { return (unsigned)__builtin_amdgcn_s_getreg((3 << 11) | 20) & 0xFu; }
#define XB_SPIN(cond, bar) do { unsigned _sp = 0; while (cond) { __builtin_amdgcn_s_sleep(1); \
    if ((++_sp & 255u) == 0u) { if (xb_ld(&(bar)[XB_TMO])) break; if (_sp > XB_SPIN_CAP) { atomicAdd(&(bar)[XB_TMO], 1u); break; } } } } while (0)

struct XcdBarrier {
    unsigned* bar; unsigned x;
    volatile LAS unsigned* st;
};

__device__ __forceinline__ XcdBarrier xcd_barrier_post(unsigned* bar, volatile LAS unsigned* st) {
    XcdBarrier b; b.bar = bar; b.x = xb_xcc_id(); b.st = st;
    if (threadIdx.x == 0) (void)xb_add(&bar[XB_XCNT(b.x)], 1u);
    return b;
}
__device__ __forceinline__ void xcd_barrier_complete(unsigned* bar, unsigned x, unsigned& nloc, unsigned& nx) {
    const unsigned G = gridDim.x * gridDim.y * gridDim.z;
    unsigned sum, cnt, mine, sp = 0u;
    for (;;) {
        sum = 0u; cnt = 0u; mine = 0u;
#pragma unroll
        for (unsigned j = 0; j < 16; ++j) { const unsigned c = xb_ld(&bar[XB_XCNT(j)]); sum += c; cnt += (c > 0u) ? 1u : 0u; mine = (j == x) ? c : mine; }
        if (sum == G) break;
        __builtin_amdgcn_s_sleep(1);
        if ((++sp & 255u) == 0u) { if (xb_ld(&bar[XB_TMO])) break; if (sp > XB_SPIN_CAP) { atomicAdd(&bar[XB_TMO], 1u); break; } }
    }
    nloc = mine > 0u ? mine : 1u; nx = cnt > 0u ? cnt : 1u;
}

__device__ __forceinline__ void xcd_barrier(const XcdBarrier& b, bool leader) {
    asm volatile("s_waitcnt vmcnt(0)" ::: "memory");
    __syncthreads();
    if (leader) {
        unsigned* bar = b.bar;
        __builtin_amdgcn_s_waitcnt(0);
        unsigned nloc = b.st[0], nx = b.st[1];
        if (nloc == 0u) { xcd_barrier_complete(bar, b.x, nloc, nx); b.st[0] = nloc; b.st[1] = nx; }
        const unsigned old = xb_add(&bar[XB_XSUB(b.x)], 1u);
        const unsigned gen = old / nloc;
        if (old + 1u == (gen + 1u) * nloc) {
            __builtin_amdgcn_fence(__ATOMIC_RELEASE, "agent");
            asm volatile("s_waitcnt vmcnt(0)" ::: "memory");
            const unsigned og = xb_add(&bar[XB_TOP], 1u);
            const unsigned tg = og / nx;
            if (og + 1u == (tg + 1u) * nx) xb_add(&bar[XB_TOPGEN], 1u);
            else XB_SPIN(xb_ld(&bar[XB_TOPGEN]) == tg, bar);
            __builtin_amdgcn_fence(__ATOMIC_ACQUIRE, "agent");
            xb_add(&bar[XB_XGEN(b.x)], 1u);
            asm volatile("s_waitcnt vmcnt(0)" ::: "memory");
        } else {
            XB_SPIN(xb_ld(&bar[XB_XGEN(b.x)]) == gen, bar);
            __builtin_amdgcn_fence(__ATOMIC_ACQUIRE, "agent");
            asm volatile("s_waitcnt vmcnt(0)" ::: "memory");
        }
    }
    __syncthreads();
}

__global__ void __launch_bounds__(NTHREADS, 2) fwd_megakernel(Params P) {
    extern __shared__ __attribute__((aligned(16))) unsigned char lds[];
    cg::grid_group grid = cg::this_grid();
    const int wave_s = __builtin_amdgcn_readfirstlane((int)threadIdx.x >> 6);
    {
        volatile LAS unsigned* misc0 = (volatile LAS unsigned*)((LAS unsigned char*)lds + MISC_OFF);
        if (threadIdx.x < 16) misc0[threadIdx.x] = 0u;
        __syncthreads();
        (void)xcd_barrier_post((unsigned*)(kp()->ws + WS_CTL), misc0 + 8);
    }
#define SLOT_BEGIN(c0_) { int gqs_ = (int)gridDim.x; asm volatile("" : "+s"(gqs_)); const int c0s_ = (gqs_ == 256) ? (c0_) : 0; if (bx >= c0s_) { PHASE_IDS(); LAS float* scr = (LAS float*)(ldsp + wave * 16384); const int gws = (bx - c0s_) * NWAVES + wave, NGWS = (gqs_ - c0s_) * NWAVES; int base = 0; (void)gw;
#define SLOT_T(W_, K_, N_, WT_, LDK_) transpose_matrix(W_, K_, N_, WT_, 0, scr, gws, NGWS, lane, base, LDK_)
#define SLOT_END() } }
#define GSYNC() do { XcdBarrier b_; b_.bar = (unsigned*)(kp()->ws + WS_CTL); b_.x = xb_xcc_id(); b_.st = (volatile LAS unsigned*)((LAS unsigned char*)lds + MISC_OFF) + 8; xcd_barrier(b_, opaque_tid(wave_s) == 0); } while (0)
    PG8_LAS unsigned char* ldsp = (PG8_LAS unsigned char*)lds;
    const int G = gridDim.x, bx = blockIdx.x, NGW = G * NWAVES;
#define PHASE_IDS() const int tid = opaque_tid(wave_s), lane = tid & 63, wave = __builtin_amdgcn_readfirstlane(tid >> 6), gw = bx * NWAVES + wave; (void)lane; (void)gw
#define WSB (kp()->ws)
#define X_IN (kp()->in[0])
#define MEM_IN (kp()->in[1])
#define Win_t0 ((bf16*)(WSB + WS_WIN0))
#define Win_t1 ((bf16*)(WSB + WS_WIN1))
#define Wout_t0 ((bf16*)(WSB + WS_WOUT0))
#define Wout_t1 ((bf16*)(WSB + WS_WOUT1))
#define MEMN ((bf16*)(WSB + WS_MEMN))
#define KVM ((bf16*)(WSB + WS_KVM))
#define ROPE ((float*)(WSB + WS_ROPE))
#define HN ((bf16*)(WSB + WS_HN))
#define YC ((bf16*)(WSB + WS_YC))
#define Y_BUF ((bf16*)(WSB + WS_Y))
#define PROJ ((bf16*)(WSB + WS_PROJ))
#define OD ((bf16*)(WSB + WS_OD))
#define U_BUF ((bf16*)(WSB + WS_U))
#define QM ((bf16*)(WSB + WS_QM))
#define OM ((bf16*)(WSB + WS_OM))
#define H_BUF (kp()->out)
#define HB_BUF ((bf16*)(WSB + WS_Y + 32 * MiB))
    for (int rep_ = 0; rep_ < (PROBE == 1 ? 2 : 1); ++rep_) {
        PHASE_IDS();
        LAS float* scr = (LAS float*)(ldsp + wave * 16384);
        int base = 0;
        transpose_matrix(kp()->in[2], DM, EVEN_IN, Win_t0, 0, scr, gw, NGW, lane, base);
        for (int l = 0; l < 2; ++l) {
            transpose_matrix(kp()->in[19] + (size_t)l * DM * MEMW, DM, MEMW, (bf16*)(WSB + WS_WKV + l * 4 * MiB), 0, scr, gw, NGW, lane, base);
            transpose_matrix(kp()->in[20] + (size_t)l * DM * MEMW, DM, MEMW, (bf16*)(WSB + WS_WKV + l * 4 * MiB), MEMW, scr, gw, NGW, lane, base);
        }
        for (int i = bx * NTHREADS + tid; i < S_ * 16; i += G * NTHREADS) {
            const int pos = i >> 4, k = i & 15;
            const float inv = (float)exp2(-(double)k * (18.931568569324174 / 16.0));
            const float ang = (float)pos * inv;
            double t = (double)ang * 0.15915494309189535; t -= rint(t);
            const float fr = (float)t;
            ROPE[2 * i] = __builtin_amdgcn_cosf(fr); ROPE[2 * i + 1] = __builtin_amdgcn_sinf(fr);
        }
        for (int m = gw; m < 2 * MEMLEN; m += NGW) { const int l = m / MEMLEN, r = m % MEMLEN;
            rms_row_bf16(MEM_IN + (size_t)r * DM, kp()->in[15] + l * DM, MEMN + (size_t)m * DM, lane); }
        for (int m = gw; m < S_; m += NGW) rms_row_bf16(X_IN + (size_t)m * DM, kp()->in[13], HN + (size_t)m * DM, lane);
    }
    if (gridDim.x == 0x7fffffffu) grid.sync();
    GSYNC();

    for (int layer = 0; layer < 2; ++layer) {

        if (layer == 0) {
            run_gemm(ldsp, wave_s, HN, Win_t0, S_, EVEN_IN, DM, pg8::EpiBf16Rope{PROJ, EVEN_IN, ROPE, 24, 34});
            for (int l = 0; l < 2; ++l)
                run_gemm(ldsp, wave_s, MEMN + (size_t)l * MEMLEN * DM, (const bf16*)(WSB + WS_WKV + l * 4 * MiB), MEMLEN, 2 * MEMW, DM, pg8::EpiBf16<0>{KVM + (size_t)l * MEMLEN * 2 * MEMW, 2 * MEMW}, 64 + 4 * l);
            SLOT_BEGIN(64)
                SLOT_T(kp()->in[3], DM, DM, Wout_t0, 0);
                SLOT_T(kp()->in[18], DM, MEMW, (bf16*)(WSB + WS_WQ), 0);
                SLOT_T(kp()->in[21], MEMW, DM, (bf16*)(WSB + WS_WO), 0);
                SLOT_T(kp()->in[24], DM, DFF, (bf16*)(WSB + WS_WUP), 0);
                SLOT_T(kp()->in[25], DFF, DM, (bf16*)(WSB + WS_WDN), 0);
            SLOT_END()
        } else {
            run_gemm(ldsp, wave_s, HN, Win_t1, S_, ODD_IN, DM, pg8::EpiBf16Rope{PROJ, ODD_IN, ROPE, 0, 32});
        }
        GSYNC();
        if (layer == 0) {
            PHASE_IDS();
            const int r32 = lane & 31, hi = lane >> 5;
            for (int u = bx; u < 512; u += G) {
                const int kind = u >> 8, uu = u & 255, hd = uu & 7, qb = uu >> 3;
                if (kind == 0) {
                    LAS float* tab = (LAS float*)(ldsp + NA_TAB_OFF);
                    __syncthreads();
                    if (tid < 465) tab[tid] = kp()->in[4][hd * 465 + tid] * (1.f / att::SCALE);
                    __syncthreads();
                    const int i0 = 4 * qb, kr0 = min(max(i0 - 4, 0), 120), thi = min(max(i0 - 1, 0), 120) + 7;
                    int NT = thi - kr0 + 1; NT += NT & 1;
                    const int qi = i0 + (wave >> 1), qj = 32 * (wave & 1) + r32;
                    att::ModNA mod{kr0, qi, qj, min(max(qi - 4, 0), 120), min(max(qj - 8, 0), 48), hi, tab};
                    if (EN_NA) att::attn_body<EVEN_IN, EVEN_IN, DM, att::ModNA>(PROJ + (size_t)(256 * qb) * EVEN_IN + hd * 128, PROJ + (size_t)(kr0 * 64) * EVEN_IN + 1024 + hd * 128,
                        PROJ + (size_t)(kr0 * 64) * EVEN_IN + 2048 + hd * 128, YC + (size_t)(256 * qb) * DM + hd * 128, NT, (char*)lds, wave_s, mod, -1e30f, 0.f);
                } else {
                    const int q0 = 256 * qb, ks = max(q0 - 128, 0), ke = min(q0 + 384, S_), NT = (ke - ks) / 64, kvh = hd >> 2;
                    att::ModSWA mod{q0 + wave * 32 + r32 - ks, hi, q0 + wave * 32 - ks};
                    const float sink = kp()->in[5][hd];
                    if (EN_SWA) att::attn_body<EVEN_IN, EVEN_IN, DM, att::ModSWA>(PROJ + (size_t)q0 * EVEN_IN + 3072 + hd * 128, PROJ + (size_t)ks * EVEN_IN + 4096 + kvh * 128,
                        PROJ + (size_t)ks * EVEN_IN + 4352 + kvh * 128, YC + (size_t)q0 * DM + 1024 + hd * 128, NT, (char*)lds, wave_s, mod, sink * (1.f / att::SCALE), 1.f);
                }
            }
        } else {
            for (int rep_ = 0; rep_ < (PROBE == 2 ? 2 : 1); ++rep_)
            for (int u = bx; u < 1024; u += G) {
                const int i = u >> 8, c = u & 255, combo = 2 * (c & 7) + (i >> 1), qb = (i & 1) * 32 + (c >> 3);
                const int h = combo >> 1;
                if (EN_DIFF) att::attn_dv256_body<ODD_IN, ODD_IN, ODD_IN, 4096>(PROJ + (size_t)(128 * qb) * ODD_IN + combo * 128, PROJ + 2048 + combo * 128,
                    PROJ + 4096 + h * 256, OD + (size_t)(128 * qb) * 4096 + combo * 256, S_ / 64, (char*)lds, wave_s);
            }
            if (G == 256) { asm volatile("s_waitcnt vmcnt(0)" ::: "memory"); __syncthreads(); } else GSYNC();
            {
                PHASE_IDS();
                const float a1 = kp()->in[8][lane] * kp()->in[9][lane] + kp()->in[8][lane + 64] * kp()->in[9][lane + 64];
                const float a2 = kp()->in[10][lane] * kp()->in[11][lane] + kp()->in[10][lane + 64] * kp()->in[11][lane + 64];
                const float lam = expf(wave_sum(a1)) - expf(wave_sum(a2)) + LAMBDA_INIT1;
                const f32x4 gg = ((const f32x4*)kp()->in[12])[lane];
                const int nit = (G == 256) ? 256 : S_ * 8;
                for (int it = (G == 256) ? wave : gw; it < nit; it += (G == 256) ? NWAVES : NGW) {
                    const int row = (G == 256) ? 128 * ((it >> 7) * 32 + (bx >> 3)) + (it & 127) : it >> 3, h = (G == 256) ? (bx & 7) : it & 7;
                    const v2u o0 = *((const v2u*)(OD + (size_t)row * 4096 + (h * 2) * 256) + lane), o1 = *((const v2u*)(OD + (size_t)row * 4096 + (h * 2 + 1) * 256) + lane);
                    f32x4 d; d.x = bf_lo(o0.x) - lam * bf_lo(o1.x); d.y = bf_hi(o0.x) - lam * bf_hi(o1.x); d.z = bf_lo(o0.y) - lam * bf_lo(o1.y); d.w = bf_hi(o0.y) - lam * bf_hi(o1.y);
                    const float ss = wave_sum((d.x * d.x + d.y * d.y) + (d.z * d.z + d.w * d.w));
                    const float rinv = (1.f - LAMBDA_INIT1) / sqrtf(ss * (1.f / 256.f) + EPS);
                    v2u w; w.x = pk2(d.x * rinv * gg.x, d.y * rinv * gg.y); w.y = pk2(d.z * rinv * gg.z, d.w * rinv * gg.w);
                    *((v2u*)(YC + (size_t)row * DM + h * 256) + lane) = w;
                }
            }
        }
        GSYNC();
        run_gemm(ldsp, wave_s, YC, (layer == 0 ? Wout_t0 : Wout_t1), S_, DM, DM, pg8::EpiBf16<0>{Y_BUF, DM});
        GSYNC();
        if (layer == 0) resid_phase<true, false>(wave_s, X_IN, Y_BUF, kp()->in[14], kp()->in[16], HB_BUF, HN);
        else resid_phase<false, false>(wave_s, HB_BUF, Y_BUF, kp()->in[14] + DM, kp()->in[16] + DM, HB_BUF, HN);
        GSYNC();
        run_gemm(ldsp, wave_s, HN, (const bf16*)(WSB + WS_WQ + layer * 2 * MiB), S_, MEMW, DM, pg8::EpiBf16<0>{QM, MEMW});
        if (layer == 0) {
            SLOT_BEGIN(64)
                SLOT_T(kp()->in[6], DM, ODD_IN, Win_t1, 0);
                SLOT_T(kp()->in[7], DM, DM, Wout_t1, 0);
                SLOT_T(kp()->in[18] + (size_t)DM * MEMW, DM, MEMW, (bf16*)(WSB + WS_WQ + 2 * MiB), 0);
                SLOT_T(kp()->in[21] + (size_t)MEMW * DM, MEMW, DM, (bf16*)(WSB + WS_WO + 2 * MiB), 0);
                SLOT_T(kp()->in[24] + (size_t)DM * DFF, DM / 2, DFF, (bf16*)(WSB + WS_WUP + 32 * MiB), DM);
            SLOT_END()
        } else {
            SLOT_BEGIN(64)
                SLOT_T(kp()->in[24] + (size_t)DM * DFF + (size_t)(DM / 2) * DFF, DM / 2, DFF, (bf16*)(WSB + WS_WUP + 32 * MiB) + DM / 2, DM);
                SLOT_T(kp()->in[25] + (size_t)DFF * DM, DFF, DM, (bf16*)(WSB + WS_WDN + 32 * MiB), 0);
            SLOT_END()
        }
        GSYNC();
        for (int u = bx; u < 128; u += G) {
            const int hd = u & 3, qb = u >> 2; const bf16* kv = KVM + (size_t)layer * MEMLEN * 2 * MEMW;
            if (EN_MEM) att::attn_body<MEMW, 2 * MEMW, MEMW, att::ModNone>(QM + (size_t)(256 * qb) * MEMW + hd * 128, kv + hd * 128, kv + MEMW + hd * 128,
                OM + (size_t)(256 * qb) * MEMW + hd * 128, MEMLEN / 64, (char*)lds, wave_s, att::ModNone{}, -1e30f, 0.f);
        }
        GSYNC();
        run_gemm(ldsp, wave_s, OM, (const bf16*)(WSB + WS_WO + layer * 2 * MiB), S_, DM, MEMW, pg8::EpiBf16<0>{Y_BUF, DM});
        GSYNC();
        resid_phase<false, false>(wave_s, HB_BUF, Y_BUF, kp()->in[17] + layer * DM, kp()->in[22] + layer * DM, HB_BUF, HN);
        GSYNC();
        for (int rep_ = 0; rep_ < ((PROBE == 3 && layer == 0) ? 2 : 1); ++rep_) {
        run_gemm(ldsp, wave_s, HN, (const bf16*)(WSB + WS_WUP + layer * 32 * MiB), S_, DFF, DM, pg8::EpiBf16<1>{U_BUF, DFF});
        GSYNC();
        run_gemm(ldsp, wave_s, U_BUF, (const bf16*)(WSB + WS_WDN + layer * 32 * MiB), S_, DM, DFF, pg8::EpiBf16<0>{Y_BUF, DM});
        GSYNC();
        }
        if (layer == 0) resid_phase<false, false>(wave_s, HB_BUF, Y_BUF, kp()->in[23], kp()->in[13] + DM, HB_BUF, HN);
        else resid_phase<false, true>(wave_s, HB_BUF, Y_BUF, kp()->in[23] + DM, nullptr, H_BUF, HN);
        if (layer == 0) GSYNC();
    }
}

extern "C" void kernel_launch(void* const* d_in, const int* in_sizes, int n_in, void* d_out, int out_size, void* d_ws, size_t ws_size, hipStream_t stream) {
    static int grid = 0;
    if (grid == 0) {
        if (n_in != 26 || out_size != S_ * DM || ws_size < WS_END) { fprintf(stderr, "kernel_launch: unexpected shapes: n_in %d out %d ws %zu (need %zu)\n", n_in, out_size, ws_size, (size_t)WS_END); grid = -1; return; }
        int dev = 0, cus = 0, per_cu = 0;
        hipGetDevice(&dev); hipDeviceGetAttribute(&cus, hipDeviceAttributeMultiprocessorCount, dev);
        if (hipFuncSetAttribute((const void*)fwd_megakernel, hipFuncAttributeMaxDynamicSharedMemorySize, LDS_BYTES) != hipSuccess) { fprintf(stderr, "kernel_launch: hipFuncSetAttribute failed\n"); grid = -1; return; }
        if (hipOccupancyMaxActiveBlocksPerMultiprocessor(&per_cu, (const void*)fwd_megakernel, NTHREADS, LDS_BYTES) != hipSuccess || per_cu < 1) { fprintf(stderr, "kernel_launch: occupancy query says %d\n", per_cu); per_cu = 1; }
        (void)hipGetLastError();
        grid = cus;
        if (grid != 256) fprintf(stderr, "kernel_launch: %d CUs (expected 256)\n", grid);
    }
    if (grid < 0) return;
    if (hipMemsetAsync((char*)d_ws + WS_CTL, 0, CTL_ZERO_BYTES, stream) != hipSuccess) { fprintf(stderr, "kernel_launch: memset failed\n"); return; }
    Params p{};
    for (int i = 0; i < 26; ++i) p.in[i] = (const float*)d_in[i];
    p.out = (float*)d_out; p.ws = (unsigned char*)d_ws;
    void* args[] = {&p};
    hipError_t e = hipLaunchCooperativeKernel((const void*)fwd_megakernel, dim3(grid), dim3(NTHREADS), args, LDS_BYTES, stream);
    if (e != hipSuccess) fprintf(stderr, "kernel_launch: cooperative launch failed: %s (grid %d)\n", hipGetErrorString(e), grid);
}
```

```cpp
#include <hip/hip_runtime.h>
#include <hip/hip_cooperative_groups.h>
#include <cstdio>
#include <cstdint>
namespace cg = cooperative_groups;
__device__ __forceinline__ int opaque_tid(int wv) { int t; asm volatile("v_mbcnt_lo_u32_b32 %0, -1, 0\n\tv_mbcnt_hi_u32_b32 %0, -1, %0\n\tv_lshl_add_u32 %0, %1, 6, %0" : "=&v"(t) : "s"(wv)); return t; }

namespace pg8 {
#define PG8_LAS __attribute__((address_space(3)))
typedef unsigned short bf16_t;
typedef short bf16x8 __attribute__((ext_vector_type(8)));
typedef float f32x4 __attribute__((ext_vector_type(4)));
typedef unsigned u32x4 __attribute__((ext_vector_type(4)));
constexpr int BM = 256, BK = 64, HALF = 128, HTB = HALF * BK * 2  , STAGE_BYTES = 8 * HTB, NXCD = 8, WGM = 4;

__host__ __device__ __forceinline__ int lds_byte(int r, int c) { const int st = (r >> 4) * 2 + (c >> 5), rr = r & 15, cc = c & 31, ob = rr * 64 + cc * 2; return st * 1024 + (ob ^ (((ob >> 9) & 1) << 5)); }
__host__ __device__ __forceinline__ void stage_rc(int b, int& R, int& C) { const int st = b / 1024, sb = b % 1024, swz = sb ^ (((sb >> 9) & 1) << 5); R = (st >> 1) * 16 + swz / 64; C = (st & 1) * 32 + (swz % 64) / 2; }
__host__ __device__ __forceinline__ int perm32(int rho) { const int n = rho >> 4, i = rho & 15; return 8 * (i >> 2) + 4 * n + (i & 3); }

struct Unit { int pm, pn; };
struct Gemm { const bf16_t* A; const bf16_t* Bt; int M, N, K; };

struct StaticOrder {
    int nM, nN, nwg, G, c;
    __host__ __device__ void init(int M, int N, int G_, int c_) { nM = M / BM; nN = N / BM; nwg = nM * nN; G = G_; c = c_; }
    __host__ __device__ bool next(int i, Unit& u) const {
        const long L = (long)i * G + c; if (L >= nwg) return false;
        int wgid = (int)L; { const int q = nwg / NXCD, r = nwg % NXCD, xcd = wgid % NXCD, off = wgid / NXCD; wgid = (xcd < r ? xcd * (q + 1) : r * (q + 1) + (xcd - r) * q) + off; }
        const int nig = WGM * nN, gid = wgid / nig, fm = gid * WGM, gsz = (nM - fm) < WGM ? (nM - fm) : WGM;
        u.pm = fm + ((wgid % nig) % gsz); u.pn = (wgid % nig) / gsz; return true;
    }
    __device__ __forceinline__ void a_ready(const Unit&) const {}
    __device__ __forceinline__ void done(const Unit&) const {}
};

__device__ __forceinline__ unsigned cvt_pk_bf16(float lo, float hi) { unsigned r; asm volatile("v_cvt_pk_bf16_f32 %0, %1, %2" : "=v"(r) : "v"(lo), "v"(hi)); return r; }
struct EpiF32 {
    static constexpr int ID = 2; static constexpr bool PERM = false, AFTER_DRAIN = false;
    float* C; int ldc;
    __device__ __forceinline__ void operator()(const f32x4 (&acc)[2][2][4][2], const Unit& u, int wr, int wc, int fr, int fq) const {
        const int row0 = u.pm * BM + wr * 64 + fr, col0 = u.pn * BM + wc * 32 + 4 * fq;
#pragma unroll
        for (int ai = 0; ai < 2; ++ai)
#pragma unroll
            for (int m = 0; m < 4; ++m) { float* rowp = C + (size_t)(row0 + ai * HALF + m * 16) * ldc + col0;
#pragma unroll
                for (int bj = 0; bj < 2; ++bj)
#pragma unroll
                    for (int n = 0; n < 2; ++n) *(f32x4*)(rowp + bj * HALF + n * 16) = acc[ai][bj][m][n]; }
    }
    __device__ __forceinline__ void fused(f32x4 (&)[2][2][4][2], const Unit&, int, int, int, int, PG8_LAS unsigned char*, int, int) const {}
};
template <int ACT  > struct EpiBf16 {
    static constexpr int ID = ACT; static constexpr bool PERM = true, AFTER_DRAIN = false;
    bf16_t* O; int ldc;
    __device__ __forceinline__ void operator()(const f32x4 (&acc)[2][2][4][2], const Unit& u, int wr, int wc, int fr, int fq) const {
        const int row0 = u.pm * BM + wr * 64 + fr; const int col0 = u.pn * BM + wc * 32 + 8 * fq;
#pragma unroll
        for (int ai = 0; ai < 2; ++ai)
#pragma unroll
            for (int m = 0; m < 4; ++m) { bf16_t* rowp = O + (size_t)(row0 + ai * HALF + m * 16) * ldc + col0;
#pragma unroll
                for (int bj = 0; bj < 2; ++bj) { f32x4 v0 = acc[ai][bj][m][0], v1 = acc[ai][bj][m][1];
                    if (ACT == 1) {
#pragma unroll
                        for (int j = 0; j < 4; ++j) { const float a = fmaxf(v0[j], 0.f), b = fmaxf(v1[j], 0.f); v0[j] = a * a; v1[j] = b * b; } }
                    u32x4 w; w.x = cvt_pk_bf16(v0[0], v0[1]); w.y = cvt_pk_bf16(v0[2], v0[3]); w.z = cvt_pk_bf16(v1[0], v1[1]); w.w = cvt_pk_bf16(v1[2], v1[3]);
                    *(u32x4*)(rowp + bj * HALF) = w; } }
    }
    __device__ __forceinline__ void fused(f32x4 (&)[2][2][4][2], const Unit&, int, int, int, int, PG8_LAS unsigned char*, int, int) const {}
};

struct EpiBf16Rope {
    static constexpr int ID = 0; static constexpr bool PERM = true, AFTER_DRAIN = false;
    bf16_t* O; int ldc; const float* rope; int head_lo, head_hi;
    __device__ __forceinline__ static float rot(float x, float c, float s, int hi) {
        auto rr = __builtin_amdgcn_permlane32_swap(__float_as_uint(x), __float_as_uint(x), false, false);
        const float y = __uint_as_float(hi ? rr[0] : rr[1]);
        return x * c + y * (hi ? s : -s);
    }
    __device__ __forceinline__ void operator()(const f32x4 (&acc)[2][2][4][2], const Unit& u, int wr, int wc, int fr, int fq) const {
        const int row0 = u.pm * BM + wr * 64 + fr; const int col0 = u.pn * BM + wc * 32 + 8 * fq;
        const int h0 = 2 * u.pn, h1 = h0 + 1, hi = fq >> 1;
        const bool r0 = (wc == 0) && h0 >= head_lo && h0 < head_hi, r1 = (wc == 0) && h1 >= head_lo && h1 < head_hi;
#pragma unroll
        for (int ai = 0; ai < 2; ++ai)
#pragma unroll
            for (int m = 0; m < 4; ++m) { const int row = row0 + ai * HALF + m * 16; bf16_t* rowp = O + (size_t)row * ldc + col0;
                const f32x4* tp = (const f32x4*)(rope + ((size_t)row * 16 + 8 * (fq & 1)) * 2);
#pragma unroll
                for (int bj = 0; bj < 2; ++bj) { f32x4 v0 = acc[ai][bj][m][0], v1 = acc[ai][bj][m][1];
                    if (bj == 0 ? r0 : r1) {
                        { const f32x4 t0 = tp[0], t1 = tp[1];
                          v0[0] = rot(v0[0], t0[0], t0[1], hi); v0[1] = rot(v0[1], t0[2], t0[3], hi); v0[2] = rot(v0[2], t1[0], t1[1], hi); v0[3] = rot(v0[3], t1[2], t1[3], hi); }
                        { const f32x4 t2 = tp[2], t3 = tp[3];
                          v1[0] = rot(v1[0], t2[0], t2[1], hi); v1[1] = rot(v1[1], t2[2], t2[3], hi); v1[2] = rot(v1[2], t3[0], t3[1], hi); v1[3] = rot(v1[3], t3[2], t3[3], hi); } }
                    u32x4 w; w.x = cvt_pk_bf16(v0[0], v0[1]); w.y = cvt_pk_bf16(v0[2], v0[3]); w.z = cvt_pk_bf16(v1[0], v1[1]); w.w = cvt_pk_bf16(v1[2], v1[3]);
                    *(u32x4*)(rowp + bj * HALF) = w; } }
    }
};

template <class Epi, class Sched, bool ALIGN_EPI = false, bool SP2 = false>
__device__ __forceinline__ void gemm_phase(PG8_LAS unsigned char* lds, const Gemm g, const Sched& S, const Epi& E, int wv) {
    const int tid = opaque_tid(wv), wid = __builtin_amdgcn_readfirstlane(tid >> 6), lane = tid & 63, wr = wid >> 2, wc = wid & 3, fr = lane & 15, fq = lane >> 4;
    const int K = g.K, nt = K / BK;
    unsigned voffA[2], voffB[2];
#pragma unroll
    for (int i = 0; i < 2; ++i) { int R, C; stage_rc(tid * 16 + i * 8192, R, C); const int Rb = Epi::PERM ? ((R & ~31) + perm32(R & 31)) : R;
        voffA[i] = (unsigned)(R * K + C) * 2u; voffB[i] = (unsigned)(Rb * K + C) * 2u; }
    const size_t kstep = (size_t)(BK * 2);
    const size_t hstep = (size_t)HALF * K * 2;
    const size_t tstep = 2 * hstep;
    const unsigned ldsw = (unsigned)wid * 1024u;
    const int aoff = lds_byte(wr * 64 + fr, fq * 8), boff = lds_byte(wc * 32 + fr, fq * 8);
#define PG8_SA(b, h) (((b) * 2 + (h)) * HTB)
#define PG8_SB(b, h) ((4 + (b) * 2 + (h)) * HTB)
#define PG8_STAGE(bufoff, gbase, voff) do { _Pragma("unroll") for (int _i = 0; _i < 2; ++_i) \
        __builtin_amdgcn_global_load_lds((const unsigned*)((const char*)(gbase) + (voff)[_i]), (PG8_LAS unsigned*)(lds + (bufoff) + ldsw + _i * 8192), 16, 0, 0); } while (0)
#define PG8_LDA(dst, b, h) do { _Pragma("unroll") for (int m = 0; m < 4; ++m) _Pragma("unroll") for (int k = 0; k < 2; ++k) dst[m][k] = *(const PG8_LAS bf16x8*)(lds + PG8_SA(b, h) + aoff + m * 2048 + k * 1024); } while (0)
#define PG8_LDB(dst, b, h) do { _Pragma("unroll") for (int n = 0; n < 2; ++n) _Pragma("unroll") for (int k = 0; k < 2; ++k) dst[n][k] = *(const PG8_LAS bf16x8*)(lds + PG8_SB(b, h) + boff + n * 2048 + k * 1024); } while (0)
#define PG8_MMA(ai, bj, At, Bt) do { __builtin_amdgcn_s_setprio(1); _Pragma("unroll") for (int m = 0; m < 4; ++m) _Pragma("unroll") for (int n = 0; n < 2; ++n) _Pragma("unroll") for (int k = 0; k < 2; ++k) \
        acc[ai][bj][m][n] = __builtin_amdgcn_mfma_f32_16x16x32_bf16(Bt[n][k], At[m][k], acc[ai][bj][m][n], 0, 0, 0); __builtin_amdgcn_s_setprio(0); } while (0)
#define PG8_WAIT_V(n) asm volatile("s_waitcnt vmcnt(" #n ")" ::: "memory")
#define PG8_WAIT_L(n) asm volatile("s_waitcnt lgkmcnt(" #n ")" ::: "memory")
#define PG8_BAR __builtin_amdgcn_s_barrier()
#define PG8_SCHED __builtin_amdgcn_sched_barrier(0)
    Unit cur, nxt; int ui = 0;
    if (!S.next(0, cur)) return;
    f32x4 acc[2][2][4][2];
#pragma unroll
    for (int a = 0; a < 2; ++a)
#pragma unroll
        for (int b = 0; b < 2; ++b)
#pragma unroll
            for (int m = 0; m < 4; ++m)
#pragma unroll
                for (int n = 0; n < 2; ++n) acc[a][b][m][n] = (f32x4){0.f, 0.f, 0.f, 0.f};
    bf16x8 At[4][2], B0[2][2], B1[2][2];
    const char* cA = (const char*)g.A + (size_t)cur.pm * tstep; const char* cB = (const char*)g.Bt + (size_t)cur.pn * tstep;
    S.a_ready(cur);
    if constexpr (SP2) {
        PG8_STAGE(PG8_SB(0, 0), cB, voffB); PG8_STAGE(PG8_SB(0, 1), cB + hstep, voffB); PG8_STAGE(PG8_SA(0, 0), cA, voffA); PG8_STAGE(PG8_SA(0, 1), cA + hstep, voffA);
        if (wr == 1) PG8_BAR;
        PG8_WAIT_V(2); PG8_BAR;
        PG8_STAGE(PG8_SB(1, 0), cB + kstep, voffB); PG8_STAGE(PG8_SA(1, 0), cA + kstep, voffA); PG8_STAGE(PG8_SB(1, 1), cB + hstep + kstep, voffB);
        PG8_WAIT_V(6); PG8_BAR;
    } else {
        PG8_STAGE(PG8_SB(0, 0), cB, voffB); PG8_STAGE(PG8_SA(0, 0), cA, voffA); PG8_STAGE(PG8_SB(0, 1), cB + hstep, voffB); PG8_STAGE(PG8_SA(0, 1), cA + hstep, voffA);
        if (wr == 1) PG8_BAR;
        PG8_WAIT_V(4); PG8_BAR;
        PG8_STAGE(PG8_SB(1, 0), cB + kstep, voffB); PG8_STAGE(PG8_SA(1, 0), cA + kstep, voffA); PG8_STAGE(PG8_SB(1, 1), cB + hstep + kstep, voffB);
        PG8_WAIT_V(6); PG8_BAR;
    }
    for (;;) {
        const bool has_next = S.next(ui + 1, nxt);
        const char* nA = has_next ? (const char*)g.A + (size_t)nxt.pm * tstep : cA; const char* nB = has_next ? (const char*)g.Bt + (size_t)nxt.pn * tstep : cB;
        for (int t = 0; t < nt; t += 2) {
            const bool last = (t == nt - 2);
            const char* a1 = cA + (size_t)(t + 1) * kstep;
            const char* a2 = last ? nA : cA + (size_t)(t + 2) * kstep; const char* b2 = last ? nB : cB + (size_t)(t + 2) * kstep;
            const char* a3 = a2 + kstep; const char* b3 = b2 + kstep;
            if (last && has_next) S.a_ready(nxt);
            if constexpr (SP2) {
            PG8_LDB(B0, 0, 0); PG8_LDB(B1, 0, 1); PG8_SCHED; PG8_LDA(At, 0, 0); PG8_STAGE(PG8_SA(1, 1), a1 + hstep, voffA);
            PG8_WAIT_V(8); PG8_WAIT_L(0); PG8_BAR; PG8_MMA(0, 0, At, B0); PG8_MMA(0, 1, At, B1); PG8_BAR; PG8_SCHED;
            PG8_LDA(At, 0, 1); PG8_STAGE(PG8_SB(0, 0), b2, voffB); PG8_STAGE(PG8_SB(0, 1), b2 + hstep, voffB); PG8_STAGE(PG8_SA(0, 0), a2, voffA);
            PG8_WAIT_V(8); PG8_WAIT_L(0); PG8_BAR; PG8_MMA(1, 0, At, B0); PG8_MMA(1, 1, At, B1); PG8_BAR; PG8_SCHED;
            PG8_LDB(B0, 1, 0); PG8_LDB(B1, 1, 1); PG8_SCHED; PG8_LDA(At, 1, 0); PG8_STAGE(PG8_SA(0, 1), a2 + hstep, voffA);
            PG8_WAIT_V(8); PG8_WAIT_L(0); PG8_BAR; PG8_MMA(0, 0, At, B0); PG8_MMA(0, 1, At, B1); PG8_BAR; PG8_SCHED;
            PG8_LDA(At, 1, 1); PG8_STAGE(PG8_SB(1, 0), b3, voffB); PG8_STAGE(PG8_SB(1, 1), b3 + hstep, voffB); PG8_STAGE(PG8_SA(1, 0), a3, voffA);
            PG8_WAIT_V(8); PG8_WAIT_L(0); PG8_BAR; PG8_MMA(1, 0, At, B0); PG8_MMA(1, 1, At, B1); PG8_BAR; PG8_SCHED;
            } else {
            PG8_LDB(B0, 0, 0); PG8_SCHED; PG8_LDA(At, 0, 0); PG8_STAGE(PG8_SA(1, 1), a1 + hstep, voffA);
            PG8_WAIT_L(8); PG8_BAR; PG8_WAIT_L(0); PG8_MMA(0, 0, At, B0); PG8_BAR; PG8_SCHED;
            PG8_LDB(B1, 0, 1); PG8_STAGE(PG8_SB(0, 0), b2, voffB);
            PG8_BAR; PG8_WAIT_L(0); PG8_MMA(0, 1, At, B1); PG8_BAR;
            PG8_LDA(At, 0, 1); PG8_STAGE(PG8_SA(0, 0), a2, voffA);
            PG8_BAR; PG8_WAIT_L(0); PG8_MMA(1, 0, At, B0); PG8_BAR; PG8_SCHED;
            PG8_STAGE(PG8_SB(0, 1), b2 + hstep, voffB);
            PG8_WAIT_V(6); PG8_BAR; PG8_MMA(1, 1, At, B1); PG8_BAR;
            PG8_LDB(B0, 1, 0); PG8_SCHED; PG8_LDA(At, 1, 0); PG8_STAGE(PG8_SA(0, 1), a2 + hstep, voffA);
            PG8_WAIT_L(8); PG8_BAR; PG8_WAIT_L(0); PG8_MMA(0, 0, At, B0); PG8_BAR; PG8_SCHED;
            PG8_LDB(B1, 1, 1); PG8_STAGE(PG8_SB(1, 0), b3, voffB);
            PG8_BAR; PG8_WAIT_L(0); PG8_MMA(0, 1, At, B1); PG8_BAR;
            PG8_LDA(At, 1, 1); PG8_STAGE(PG8_SA(1, 0), a3, voffA);
            PG8_BAR; PG8_WAIT_L(0); PG8_MMA(1, 0, At, B0); PG8_BAR; PG8_SCHED;
            PG8_STAGE(PG8_SB(1, 1), b3 + hstep, voffB);
            PG8_WAIT_V(6); PG8_BAR; PG8_MMA(1, 1, At, B1); PG8_BAR;
            }
        }
        if constexpr (ALIGN_EPI) { if (wr == 0) PG8_BAR; }
        if constexpr (!Epi::AFTER_DRAIN) { E(acc, cur, wr, wc, fr, fq); S.done(cur); }
        if (!has_next) break;
#pragma unroll
        for (int a = 0; a < 2; ++a)
#pragma unroll
            for (int b = 0; b < 2; ++b)
#pragma unroll
                for (int m = 0; m < 4; ++m)
#pragma unroll
                    for (int n = 0; n < 2; ++n) acc[a][b][m][n] = (f32x4){0.f, 0.f, 0.f, 0.f};
        cur = nxt; cA = nA; cB = nB; ++ui;
        if constexpr (ALIGN_EPI) { if (wr == 1) PG8_BAR; }
    }
    PG8_WAIT_V(0);
    if constexpr (!ALIGN_EPI) { if (wr == 0) PG8_BAR; }
    PG8_BAR;
    if constexpr (Epi::AFTER_DRAIN) { E.fused(acc, cur, wr, wc, fr, fq, lds, wid, lane); S.done(cur); }
#undef PG8_SA
#undef PG8_SB
#undef PG8_STAGE
#undef PG8_LDA
#undef PG8_LDB
#undef PG8_MMA
#undef PG8_WAIT_V
#undef PG8_WAIT_L
#undef PG8_BAR
#undef PG8_SCHED
}
}
namespace att {
typedef unsigned short u16;
constexpr int   D = 128, NW = 8, QBLK = 32, KVBLK = 64;
constexpr float SCALE = 0.088388347648318440f;
constexpr float THR = 8.f;
constexpr size_t SHM_V = KVBLK * D * 2, SHM_K = KVBLK * D * 2, SHM_ATTN = 2 * SHM_V + 2 * SHM_K + NW * 64 * 4;
using bf16x8 = __attribute__((ext_vector_type(8))) short;
using s16x4  = __attribute__((ext_vector_type(4))) short;
using f32x16 = __attribute__((ext_vector_type(16))) float;
using u32x4  = __attribute__((ext_vector_type(4))) unsigned;
#define KSWZ(row, colB) ((row) * 256 + ((colB) ^ (((row) & 7) << 4)))
#define SBAR() __builtin_amdgcn_sched_barrier(0)
__device__ __forceinline__ int crow(int r, int hi) { return (r & 3) + 8 * (r >> 2) + 4 * hi; }
__device__ __forceinline__ unsigned cvtpk(float lo, float hi) {
  unsigned r; asm volatile("v_cvt_pk_bf16_f32 %0, %1, %2" : "=v"(r) : "v"(lo), "v"(hi)); return r;
}
__device__ __forceinline__ bf16x8 ld8(const u16* p) { return *reinterpret_cast<const bf16x8*>(p); }

__device__ __forceinline__ void partialSM(f32x16& p0, f32x16& p1, float& m_reg, float& mn, float& alpha) {
  constexpr float C = SCALE * 1.4426950408889634f;
  float pmax = p0[0]; for (int r = 1; r < 16; ++r) pmax = fmaxf(pmax, p0[r]); for (int r = 0; r < 16; ++r) pmax = fmaxf(pmax, p1[r]);
  { auto rr = __builtin_amdgcn_permlane32_swap(__float_as_uint(pmax), __float_as_uint(pmax), false, false);
    pmax = fmaxf(__uint_as_float(rr[0]), __uint_as_float(rr[1])); }
  if (__builtin_expect(__all(pmax - m_reg <= THR / SCALE), 1)) { mn = m_reg; alpha = 1.f; }
  else { mn = fmaxf(m_reg, pmax); alpha = __builtin_amdgcn_exp2f((m_reg - mn) * C); m_reg = mn; }
  float mnC = -mn * C;
  for (int r = 0; r < 16; ++r) p0[r] = fmaf(p0[r], C, mnC); for (int r = 0; r < 16; ++r) p1[r] = fmaf(p1[r], C, mnC);
  for (int r = 0; r < 16; ++r) p0[r] = __builtin_amdgcn_exp2f(p0[r]);
}
__device__ __forceinline__ void finishSM(f32x16& p0, f32x16& p1, float alpha, float& l_reg, bf16x8& pa0, bf16x8& pa1, bf16x8& pa2, bf16x8& pa3) {
  for (int r = 0; r < 16; ++r) p1[r] = __builtin_amdgcn_exp2f(p1[r]);
  float ps = 0; for (int r = 0; r < 16; ++r) ps += p0[r]; for (int r = 0; r < 16; ++r) ps += p1[r];
  { auto rr = __builtin_amdgcn_permlane32_swap(__float_as_uint(ps), __float_as_uint(ps), false, false);
    ps = __uint_as_float(rr[0]) + __uint_as_float(rr[1]); }
  l_reg = l_reg * alpha + ps;
#define PK4(P, BASE, OUT) do { unsigned a0 = cvtpk(P[BASE + 0], P[BASE + 1]), a1 = cvtpk(P[BASE + 2], P[BASE + 3]);   \
    unsigned b0 = cvtpk(P[BASE + 4], P[BASE + 5]), b1 = cvtpk(P[BASE + 6], P[BASE + 7]);                              \
    auto r0 = __builtin_amdgcn_permlane32_swap(a0, b0, false, false); auto r1 = __builtin_amdgcn_permlane32_swap(a1, b1, false, false); \
    u32x4 w = {r0[0], r1[0], r0[1], r1[1]}; OUT = *reinterpret_cast<bf16x8*>(&w); } while (0)
  PK4(p0, 0, pa0); PK4(p0, 8, pa1); PK4(p1, 0, pa2); PK4(p1, 8, pa3);
#undef PK4
}
__device__ __forceinline__ void qkt(f32x16& p0, f32x16& p1, const char* Ks, const bf16x8* qr, int r32, int hi) {
  p0 = f32x16{}; p1 = f32x16{};
  for (int d0 = 0; d0 < 8; ++d0) { int cb = (d0 * 16 + hi * 8) * 2;
    bf16x8 b0 = *reinterpret_cast<const bf16x8*>(Ks + KSWZ(r32, cb));
    bf16x8 b1 = *reinterpret_cast<const bf16x8*>(Ks + KSWZ(32 + r32, cb));
    p0 = __builtin_amdgcn_mfma_f32_32x32x16_bf16(b0, qr[d0], p0, 0, 0, 0);
    p1 = __builtin_amdgcn_mfma_f32_32x32x16_bf16(b1, qr[d0], p1, 0, 0, 0); }
}
__device__ __forceinline__ int v_st(int k, int c) { const int kk = (k & ~0xC) | ((k & 4) << 1) | ((k & 8) >> 1); return ((kk >> 3) * 4 + (c >> 5)) * 512 + ((kk & 7) * 32 + (c & 31)) * 2; }
__device__ __forceinline__ int v_rd_base(int lane) { return ((lane & 3) << 3) | (((lane >> 2) & 3) << 6) | (((lane >> 4) & 1) << 5) | (((lane >> 5) & 1) << 8); }
constexpr int v_rd_off(int d0, int ks, int half) { return d0 * 512 + ks * 4096 + half * 2048; }
template <int OFF> __device__ __forceinline__ s16x4 tr_read(int vb) {
  s16x4 r; asm volatile("ds_read_b64_tr_b16 %0, %1 offset:%2" : "=&v"(r) : "v"(vb), "i"(OFF) : "memory"); return r;
}
template <int D0> __device__ __forceinline__ void pv_one(f32x16& od, int vb, bf16x8 pa0, bf16x8 pa1, bf16x8 pa2, bf16x8 pa3) {
  const s16x4 l0 = tr_read<v_rd_off(D0, 0, 0)>(vb), h0 = tr_read<v_rd_off(D0, 0, 1)>(vb), l1 = tr_read<v_rd_off(D0, 1, 0)>(vb), h1 = tr_read<v_rd_off(D0, 1, 1)>(vb);
  const s16x4 l2 = tr_read<v_rd_off(D0, 2, 0)>(vb), h2 = tr_read<v_rd_off(D0, 2, 1)>(vb), l3 = tr_read<v_rd_off(D0, 3, 0)>(vb), h3 = tr_read<v_rd_off(D0, 3, 1)>(vb);
  asm volatile("s_waitcnt lgkmcnt(0)" ::: "memory"); SBAR();
#define PK(L, H) (bf16x8){L[0], L[1], L[2], L[3], H[0], H[1], H[2], H[3]}
  od = __builtin_amdgcn_mfma_f32_32x32x16_bf16(pa0, PK(l0, h0), od, 0, 0, 0);
  od = __builtin_amdgcn_mfma_f32_32x32x16_bf16(pa1, PK(l1, h1), od, 0, 0, 0);
  od = __builtin_amdgcn_mfma_f32_32x32x16_bf16(pa2, PK(l2, h2), od, 0, 0, 0);
  od = __builtin_amdgcn_mfma_f32_32x32x16_bf16(pa3, PK(l3, h3), od, 0, 0, 0);
#undef PK
}
__device__ __forceinline__ void pv_d0(f32x16* o, int vb, bf16x8 pa0, bf16x8 pa1, bf16x8 pa2, bf16x8 pa3) {
  pv_one<0>(o[0], vb, pa0, pa1, pa2, pa3); pv_one<1>(o[1], vb, pa0, pa1, pa2, pa3); pv_one<2>(o[2], vb, pa0, pa1, pa2, pa3); pv_one<3>(o[3], vb, pa0, pa1, pa2, pa3);
}

struct ModNone { __device__ __forceinline__ void operator()(f32x16&, f32x16&, int) const {} };
struct ModSWA { int qrel, hi;
  __device__ __forceinline__ void operator()(f32x16& p0, f32x16& p1, int t) const {
    const int x = qrel - t * 64 - 4 * hi, lo = x - 128, up = x + 128; const float ninf = -__builtin_inff();
#pragma unroll
    for (int r = 0; r < 16; ++r) { const int kc = (r & 3) + 8 * (r >> 2);
      p0[r] = (lo <= kc && up >= kc) ? p0[r] : ninf; p1[r] = (lo <= kc + 32 && up >= kc + 32) ? p1[r] : ninf; }
  } };
struct ModNA { int kr0, qi, qj, rs, cs, hi; const __attribute__((address_space(3))) float* tab;
  __device__ __forceinline__ void operator()(f32x16& p0, f32x16& p1, int t) const {
    const int kr = kr0 + t; const float ninf = -__builtin_inff();
    if (kr < rs || kr >= rs + 8) {
#pragma unroll
      for (int r = 0; r < 16; ++r) { p0[r] = ninf; p1[r] = ninf; }
    } else {
      const __attribute__((address_space(3))) float* trow = tab + ((kr - qi + 7) * 31 + 15 - qj + 4 * hi);
      const int c0 = 4 * hi - cs;
#pragma unroll
      for (int r = 0; r < 16; ++r) { const int kc = (r & 3) + 8 * (r >> 2); const int ia = kc + c0, ib = ia + 32;
        const float ba = trow[kc], bb = trow[kc + 32];
        p0[r] = ((unsigned)ia < 16u) ? p0[r] + ba : ninf; p1[r] = ((unsigned)ib < 16u) ? p1[r] + bb : ninf; }
    }
  } };

template <int LDQ, int LDK, int LDO, class Mod>
__device__ __forceinline__ void attn_body(const u16* __restrict__ Qb, const u16* __restrict__ Kh, const u16* __restrict__ Vh,
                                          u16* __restrict__ Ob, int NT, char* lds, int wv, const Mod& mod, float m_init, float l_init) {
  const int tid = opaque_tid(wv), wid = tid >> 6, lane = tid & 63, r32 = lane & 31, hi = lane >> 5;
  char* V_lds = lds; char* K_lds = lds + 2 * SHM_V;
  float* ws = (float*)(lds + 2 * SHM_V + 2 * SHM_K) + wid * 64; float* li_l = ws; float* al_l = ws + 32;
  float m_reg = m_init, l_reg = l_init; f32x16 o[4] = {}; bf16x8 qr[8];
  const u16* Qw = Qb + (long)(wid * QBLK + r32) * LDQ + hi * 8;
#pragma unroll
  for (int d0 = 0; d0 < 8; ++d0) qr[d0] = ld8(Qw + d0 * 16);
  const int sr = tid >> 4, sc = (tid & 15) * 8, vst0 = v_st(sr, sc), vst1 = v_st(32 + sr, sc);
  const int vb0 = (int)(uintptr_t)V_lds + v_rd_base(lane);
  struct { bf16x8 vs0, vs1, ks0, ks1; } sr_[1];
#define SLOAD(i, k0) do { sr_[i].vs0 = ld8(&Vh[(long)((k0) + sr) * LDK + sc]); sr_[i].vs1 = ld8(&Vh[(long)((k0) + 32 + sr) * LDK + sc]); \
    sr_[i].ks0 = ld8(&Kh[(long)((k0) + sr) * LDK + sc]); sr_[i].ks1 = ld8(&Kh[(long)((k0) + 32 + sr) * LDK + sc]); } while (0)
#define SWRITE(b, i) do { *(bf16x8*)(V_lds + (b) * SHM_V + vst0) = sr_[i].vs0;          \
    *(bf16x8*)(V_lds + (b) * SHM_V + vst1) = sr_[i].vs1; int kc = sc * 2;               \
    *(bf16x8*)(K_lds + (b) * SHM_K + KSWZ(sr, kc)) = sr_[i].ks0;                       \
    *(bf16x8*)(K_lds + (b) * SHM_K + KSWZ(32 + sr, kc)) = sr_[i].ks1; } while (0)
#define SWAIT() asm volatile("s_waitcnt vmcnt(0)" ::: "memory")
#define RESC(a) do { if (__any((a) < 1.f)) { if (hi == 0) al_l[r32] = (a); asm volatile("s_waitcnt lgkmcnt(0)" ::: "memory"); \
    for (int d = 0; d < 4; ++d) for (int r = 0; r < 16; ++r) o[d][r] *= al_l[crow(r, hi)]; } } while (0)
  f32x16 pA0, pA1, pB0, pB1; float mnA, mnB, alA, alB; bf16x8 pa0, pa1, pa2, pa3;
  constexpr int SE = 0, SO = 0;
  SLOAD(SE, 0); asm volatile("s_waitcnt vmcnt(0)" ::: "memory"); SWRITE(0, SE); __syncthreads();
  qkt(pA0, pA1, K_lds, qr, r32, hi); mod(pA0, pA1, 0); partialSM(pA0, pA1, m_reg, mnA, alA);
  SLOAD(SO, KVBLK);
  SWAIT(); SWRITE(1, SO); __syncthreads();
  for (int j = 1; j + 1 < NT; j += 2) {
    SBAR(); qkt(pB0, pB1, K_lds + SHM_K, qr, r32, hi);
    finishSM(pA0, pA1, alA, l_reg, pa0, pa1, pa2, pa3); SBAR();
    SLOAD(SO, (j + 1) * KVBLK); SBAR();
    pv_d0(o, vb0, pa0, pa1, pa2, pa3); mod(pB0, pB1, j); partialSM(pB0, pB1, m_reg, mnB, alB);
    __syncthreads(); SWAIT(); SWRITE(0, SE);
    RESC(alB); __syncthreads();
    SBAR(); qkt(pA0, pA1, K_lds, qr, r32, hi);
    finishSM(pB0, pB1, alB, l_reg, pa0, pa1, pa2, pa3); SBAR();
    SLOAD(SE, (j + 2) * KVBLK); SBAR();
    pv_d0(o, vb0 + (int)SHM_V, pa0, pa1, pa2, pa3); mod(pA0, pA1, j + 1); partialSM(pA0, pA1, m_reg, mnA, alA);
    __syncthreads(); SWAIT(); SWRITE(1, SO);
    RESC(alA); __syncthreads();
  }
  SBAR(); qkt(pB0, pB1, K_lds + SHM_K, qr, r32, hi);
  finishSM(pA0, pA1, alA, l_reg, pa0, pa1, pa2, pa3); SBAR();
  pv_d0(o, vb0, pa0, pa1, pa2, pa3); mod(pB0, pB1, NT - 1); partialSM(pB0, pB1, m_reg, mnB, alB);
  __syncthreads(); RESC(alB);
  finishSM(pB0, pB1, alB, l_reg, pa0, pa1, pa2, pa3); SBAR();
  pv_d0(o, vb0 + (int)SHM_V, pa0, pa1, pa2, pa3);
  if (hi == 0) li_l[r32] = l_reg; asm volatile("s_waitcnt lgkmcnt(0)" ::: "memory");
  float rli[16];
#pragma unroll
  for (int r = 0; r < 16; ++r) rli[r] = __builtin_amdgcn_rcpf(li_l[crow(r, hi)]);
  u16* Ow = Ob + (long)(wid * QBLK) * LDO;
#pragma unroll
  for (int r = 0; r < 16; ++r) { int orow = crow(r, hi);
#pragma unroll
    for (int d0 = 0; d0 < 4; ++d0) Ow[(long)orow * LDO + d0 * 32 + r32] = (u16)cvtpk(o[d0][r] * rli[r], 0.f); }
  __syncthreads();
#undef SLOAD
#undef SWRITE
#undef SWAIT
#undef RESC
}
#define PVR(HB, S) const s16x4 S##l0 = tr_read<v_rd_off((HB) >> 1, 2 * ((HB) & 1), 0)>(vb), S##h0 = tr_read<v_rd_off((HB) >> 1, 2 * ((HB) & 1), 1)>(vb), \
    S##l1 = tr_read<v_rd_off((HB) >> 1, 2 * ((HB) & 1) + 1, 0)>(vb), S##h1 = tr_read<v_rd_off((HB) >> 1, 2 * ((HB) & 1) + 1, 1)>(vb)
#define PVK(L, H) (bf16x8){L[0], L[1], L[2], L[3], H[0], H[1], H[2], H[3]}
#define PVM(HB, S, PA, PB) do { o[(HB) >> 1] = __builtin_amdgcn_mfma_f32_32x32x16_bf16(PA, PVK(S##l0, S##h0), o[(HB) >> 1], 0, 0, 0); \
    o[(HB) >> 1] = __builtin_amdgcn_mfma_f32_32x32x16_bf16(PB, PVK(S##l1, S##h1), o[(HB) >> 1], 0, 0, 0); } while (0)
#define PVW(N) do { asm volatile("s_waitcnt lgkmcnt(" #N ")" ::: "memory"); SBAR(); } while (0)
__device__ __forceinline__ void pv_pipe(f32x16* o, int vb, bf16x8 pa0, bf16x8 pa1, bf16x8 pa2, bf16x8 pa3) {
  PVR(0, a); PVR(1, b); PVR(2, c);
  PVW(8); PVM(0, a, pa0, pa1); PVR(3, d);
  PVW(8); PVM(1, b, pa2, pa3); PVR(4, e);
  PVW(8); PVM(2, c, pa0, pa1); PVR(5, f);
  PVW(8); PVM(3, d, pa2, pa3); PVR(6, g);
  PVW(8); PVM(4, e, pa0, pa1); PVR(7, h);
  PVW(8); PVM(5, f, pa2, pa3);
  PVW(4); PVM(6, g, pa0, pa1);
  PVW(0); PVM(7, h, pa2, pa3);
}
#undef PVR
#undef PVK
#undef PVM
#undef PVW
__device__ __forceinline__ void qkt_half(f32x16& p, const char* Ks, const bf16x8* qr, int krow, int hi) {
  p = f32x16{};
  for (int d0 = 0; d0 < 8; ++d0) { int cb = (d0 * 16 + hi * 8) * 2;
    bf16x8 b = *reinterpret_cast<const bf16x8*>(Ks + KSWZ(krow, cb));
    p = __builtin_amdgcn_mfma_f32_32x32x16_bf16(b, qr[d0], p, 0, 0, 0); }
}
__device__ __forceinline__ float halfmax(const f32x16& p) {
  float pmax = p[0]; for (int r = 1; r < 16; ++r) pmax = fmaxf(pmax, p[r]);
  auto rr = __builtin_amdgcn_permlane32_swap(__float_as_uint(pmax), __float_as_uint(pmax), false, false);
  return fmaxf(__uint_as_float(rr[0]), __uint_as_float(rr[1]));
}
template <int LDQ, int LDK, int LDV, int LDO>
__device__ __forceinline__ void attn_dv256_body(const u16* __restrict__ Qb, const u16* __restrict__ Kh, const u16* __restrict__ Vh, u16* __restrict__ Ob, int NT, char* lds, int wv) {
  const int tid = opaque_tid(wv), wid = __builtin_amdgcn_readfirstlane(tid >> 6), lane = tid & 63, r32 = lane & 31, hi = lane >> 5;
  const int rg = wid >> 1, ch = wid & 1;
  char* K_lds = lds;
  char* V_lds = lds + 32768;
  char* PX = lds + 98304;
  float* MX = (float*)(lds + 135168);
  float* al_l = (float*)(lds + 139264) + wid * 64;
  float* LX = (float*)(lds + 141312);
  float m_reg = -1e30f, l_reg = 0.f; f32x16 o[4] = {}; bf16x8 qr[8];
  const u16* Qw = Qb + (long)(rg * 32 + r32) * LDQ + hi * 8;
#pragma unroll
  for (int d0 = 0; d0 < 8; ++d0) qr[d0] = ld8(Qw + d0 * 16);
  const int sr = tid >> 4, sc = (tid & 15) * 8, vst0 = v_st(sr, sc), vst1 = v_st(32 + sr, sc), kcb = sc * 2;
  const int vb0 = (int)(uintptr_t)V_lds + ch * 16384 + v_rd_base(lane);
  const int pxw = (wid * 2 * 64 + lane) * 16, px0 = ((wid & ~1) * 2 * 64 + lane) * 16;
  const int krow = 32 * ch + r32;
  bf16x8 ks0, ks1, vs0, vs1, vs2, vs3;
#define KLOAD(k0) do { ks0 = ld8(&Kh[(long)((k0) + sr) * LDK + sc]); ks1 = ld8(&Kh[(long)((k0) + 32 + sr) * LDK + sc]); } while (0)
#define VLOAD(k0) do { vs0 = ld8(&Vh[(long)((k0) + sr) * LDV + sc]); vs1 = ld8(&Vh[(long)((k0) + 32 + sr) * LDV + sc]); \
    vs2 = ld8(&Vh[(long)((k0) + sr) * LDV + 128 + sc]); vs3 = ld8(&Vh[(long)((k0) + 32 + sr) * LDV + 128 + sc]); } while (0)
#define KWRITE(b) do { *(bf16x8*)(K_lds + (b) * 16384 + KSWZ(sr, kcb)) = ks0; *(bf16x8*)(K_lds + (b) * 16384 + KSWZ(32 + sr, kcb)) = ks1; } while (0)
#define VWRITE(b) do { *(bf16x8*)(V_lds + (b) * 32768 + vst0) = vs0; *(bf16x8*)(V_lds + (b) * 32768 + vst1) = vs1; \
    *(bf16x8*)(V_lds + (b) * 32768 + 16384 + vst0) = vs2; *(bf16x8*)(V_lds + (b) * 32768 + 16384 + vst1) = vs3; } while (0)
#define RESC(a) do { if (__any((a) < 1.f)) { if (hi == 0) al_l[r32] = (a); asm volatile("s_waitcnt lgkmcnt(0)" ::: "memory"); \
    for (int d = 0; d < 4; ++d) for (int r = 0; r < 16; ++r) o[d][r] *= al_l[crow(r, hi)]; } } while (0)
#define PK4(P, BASE, OUT) do { unsigned a0 = cvtpk(P[BASE + 0], P[BASE + 1]), a1 = cvtpk(P[BASE + 2], P[BASE + 3]);   \
    unsigned b0 = cvtpk(P[BASE + 4], P[BASE + 5]), b1 = cvtpk(P[BASE + 6], P[BASE + 7]);                              \
    auto r0 = __builtin_amdgcn_permlane32_swap(a0, b0, false, false); auto r1 = __builtin_amdgcn_permlane32_swap(a1, b1, false, false); \
    u32x4 w = {r0[0], r1[0], r0[1], r1[1]}; OUT = *reinterpret_cast<bf16x8*>(&w); } while (0)
  KLOAD(0); asm volatile("s_waitcnt vmcnt(0)" ::: "memory"); KWRITE(0);
  KLOAD(64); asm volatile("s_waitcnt vmcnt(0)" ::: "memory"); KWRITE(1);
  if (2 < NT) KLOAD(128);
  VLOAD(0);
  __syncthreads();
  f32x16 pC, pN; float pmC, pmN = 0.f;
  qkt_half(pC, K_lds, qr, krow, hi);
  pmC = halfmax(pC); MX[(0 * 8 + wid) * 64 + lane] = pmC;
  __syncthreads();
  for (int t = 0; t < NT; ++t) {
    const int par = t & 1;
    if (t + 1 < NT) qkt_half(pN, K_lds + (par ^ 1) * 16384, qr, krow, hi);
    if (t >= 1) {
      const bf16x8 pa0 = *(const bf16x8*)(PX + (par ^ 1) * 16384 + px0), pa1 = *(const bf16x8*)(PX + (par ^ 1) * 16384 + px0 + 1024);
      const bf16x8 pa2 = *(const bf16x8*)(PX + (par ^ 1) * 16384 + px0 + 2048), pa3 = *(const bf16x8*)(PX + (par ^ 1) * 16384 + px0 + 3072);
      pv_pipe(o, vb0 + (par ^ 1) * 32768, pa0, pa1, pa2, pa3);
    }
    float alpha;
    {
      constexpr float C = SCALE * 1.4426950408889634f;
      const float pmP = MX[(par * 8 + (wid ^ 1)) * 64 + lane];
      const float pmax = fmaxf(pmC, pmP);
      float mn;
      if (__builtin_expect(__all(pmax - m_reg <= THR / SCALE), 1)) { mn = m_reg; alpha = 1.f; }
      else { mn = fmaxf(m_reg, pmax); alpha = __builtin_amdgcn_exp2f((m_reg - mn) * C); m_reg = mn; }
      const float mnC = -mn * C;
      for (int r = 0; r < 16; ++r) pC[r] = __builtin_amdgcn_exp2f(fmaf(pC[r], C, mnC));
      float ps = 0; for (int r = 0; r < 16; ++r) ps += pC[r];
      { auto rr = __builtin_amdgcn_permlane32_swap(__float_as_uint(ps), __float_as_uint(ps), false, false);
        ps = __uint_as_float(rr[0]) + __uint_as_float(rr[1]); }
      l_reg = l_reg * alpha + ps;
      bf16x8 fo0, fo1; PK4(pC, 0, fo0); PK4(pC, 8, fo1);
      *(bf16x8*)(PX + par * 16384 + pxw) = fo0; *(bf16x8*)(PX + par * 16384 + pxw + 1024) = fo1;
    }
    RESC(alpha);
    if (t + 1 < NT) { pmN = halfmax(pN); MX[((par ^ 1) * 8 + wid) * 64 + lane] = pmN; }
    asm volatile("s_waitcnt vmcnt(0)" ::: "memory");
    if (t + 2 < NT) KWRITE(par);
    VWRITE(par);
    if (t + 3 < NT) KLOAD((t + 3) * 64);
    if (t + 1 < NT) VLOAD((t + 1) * 64);
    __syncthreads();
    pC = pN; pmC = pmN;
  }
  {
    const int par = (NT - 1) & 1;
    const bf16x8 pa0 = *(const bf16x8*)(PX + par * 16384 + px0), pa1 = *(const bf16x8*)(PX + par * 16384 + px0 + 1024);
    const bf16x8 pa2 = *(const bf16x8*)(PX + par * 16384 + px0 + 2048), pa3 = *(const bf16x8*)(PX + par * 16384 + px0 + 3072);
    pv_pipe(o, vb0 + par * 32768, pa0, pa1, pa2, pa3);
  }
  LX[wid * 64 + lane] = l_reg;
  __syncthreads();
  const float ltot = l_reg + LX[(wid ^ 1) * 64 + lane];
  if (hi == 0) al_l[r32] = ltot; asm volatile("s_waitcnt lgkmcnt(0)" ::: "memory");
  float rli[16];
#pragma unroll
  for (int r = 0; r < 16; ++r) rli[r] = __builtin_amdgcn_rcpf(al_l[crow(r, hi)]);
  u16* Ow = Ob + (long)(rg * 32) * LDO + ch * 128;
#pragma unroll
  for (int r = 0; r < 16; ++r) { int orow = crow(r, hi);
#pragma unroll
    for (int d0 = 0; d0 < 4; ++d0) Ow[(long)orow * LDO + d0 * 32 + r32] = (u16)cvtpk(o[d0][r] * rli[r], 0.f); }
  __syncthreads();
#undef KLOAD
#undef VLOAD
#undef KWRITE
#undef VWRITE
#undef RESC
#undef PK4
}
}

#ifndef PROBE
#define PROBE 0
#endif
#ifndef EN_NA
#define EN_NA 1
#endif
#ifndef EN_SWA
#define EN_SWA 1
#endif
#ifndef EN_DIFF
#define EN_DIFF 1
#endif
#ifndef EN_MEM
#define EN_MEM 1
#endif
#ifndef EN_EPI
#define EN_EPI -1
#endif
#ifndef EN_GEMM
#define EN_GEMM 1
#endif
#define LAS __attribute__((address_space(3)))
typedef unsigned short bf16;
typedef unsigned v4u __attribute__((ext_vector_type(4)));
typedef unsigned v2u __attribute__((ext_vector_type(2)));
typedef float f32x4 __attribute__((ext_vector_type(4)));
constexpr int NWAVES = 8, NTHREADS = 512;
constexpr int S_ = 8192, DM = 2048, MEMLEN = 256, DFF = 8192;
constexpr int EVEN_IN = 4608, ODD_IN = 6144, MEMW = 512;
constexpr float EPS = 1e-6f;
constexpr float LAMBDA_INIT1 = 0.35550906f;
constexpr int LDS_BYTES = 147456;
constexpr int NA_TAB_OFF = 67584 + 512;
constexpr size_t MiB = 1u << 20;
constexpr size_t WS_WIN0 = 0, WS_WOUT0 = 18 * MiB, WS_WIN1 = 26 * MiB, WS_WOUT1 = 50 * MiB, WS_WQ = 58 * MiB  , WS_WKV = 62 * MiB  ,
                 WS_WO = 70 * MiB  , WS_WUP = 74 * MiB  , WS_WDN = 138 * MiB  , WS_MEMN = 202 * MiB, WS_KVM = 204 * MiB,
                 WS_ROPE = 205 * MiB, WS_HN = 206 * MiB, WS_YC = 238 * MiB, WS_Y = 270 * MiB, WS_R1 = 334 * MiB, WS_CTL = 498 * MiB, WS_END = 499 * MiB;
constexpr size_t CTL_ZERO_BYTES = 16384;
constexpr int MISC_OFF = 131072 + 320;
constexpr size_t WS_PROJ = WS_R1, WS_OD = WS_R1 + 96 * MiB, WS_U = WS_R1, WS_QM = WS_R1, WS_OM = WS_R1 + 8 * MiB;

struct Params { const float* in[26]; float* out; unsigned char* ws; };
typedef const __attribute__((address_space(4))) Params* KPtr;
__device__ __forceinline__ KPtr kp() { KPtr p = (KPtr)__builtin_amdgcn_kernarg_segment_ptr(); asm volatile("" : "+s"(p)); return p; }

__device__ __forceinline__ unsigned f2bf(float f) { unsigned u = __builtin_bit_cast(unsigned, f); return (u + 0x7fffu + ((u >> 16) & 1u)) >> 16; }
__device__ __forceinline__ unsigned pk2(float lo, float hi) { return f2bf(lo) | (f2bf(hi) << 16); }
__device__ __forceinline__ float bf_lo(unsigned w) { return __builtin_bit_cast(float, w << 16); }
__device__ __forceinline__ float bf_hi(unsigned w) { return __builtin_bit_cast(float, w & 0xffff0000u); }
__device__ __forceinline__ float wave_sum(float v) {
#pragma unroll
    for (int o = 1; o < 64; o <<= 1) v += __shfl_xor(v, o);
    return v;
}
#define LDS_WAIT() asm volatile("s_waitcnt lgkmcnt(0)" ::: "memory")

__device__ __forceinline__ void transpose_item(const float* __restrict__ W, int K, int N, bf16* __restrict__ WT, int ldk, int row_off, LAS float* scr, int item, int lane) {
    const int nblk = N / 32, kb = item / nblk, nb = item % nblk, k0 = 64 * kb, n0 = 32 * nb;
    float tv[32];
#pragma unroll
    for (int i = 0; i < 32; ++i) { const int kk = 2 * i + (lane >> 5); tv[i] = __builtin_nontemporal_load(&W[(size_t)(k0 + kk) * N + n0 + (lane & 31)]); }
#pragma unroll
    for (int i = 0; i < 32; ++i) { const int kk = 2 * i + (lane >> 5); scr[kk * 33 + (lane & 31)] = tv[i]; }
    LDS_WAIT(); asm volatile("" ::: "memory");
    const int c = lane & 7;
#pragma unroll
    for (int j = 0; j < 4; ++j) { const int n = (lane >> 3) + 8 * j; const LAS float* s = scr + (8 * c) * 33 + n;
        v4u o; o.x = pk2(s[0 * 33], s[1 * 33]); o.y = pk2(s[2 * 33], s[3 * 33]); o.z = pk2(s[4 * 33], s[5 * 33]); o.w = pk2(s[6 * 33], s[7 * 33]);
        *(v4u*)(WT + (size_t)(row_off + n0 + n) * ldk + k0 + 8 * c) = o; }
    LDS_WAIT(); asm volatile("" ::: "memory");
}
__device__ __forceinline__ void transpose_matrix(const float* W, int K, int N, bf16* WT, int row_off, LAS float* scr, int gw, int NGW, int lane, int& base, int ldk = 0) {
    if (ldk == 0) ldk = K;
    const int items = (K / 64) * (N / 32);
    int first = (gw - base) % NGW; if (first < 0) first += NGW;
    for (int it = first; it < items; it += NGW) transpose_item(W, K, N, WT, ldk, row_off, scr, it, lane);
    base = (base + items) % NGW;
}

__device__ __forceinline__ void rms_row_bf16(const float* __restrict__ xrow, const float* __restrict__ g, bf16* __restrict__ orow, int lane) {
    const f32x4* xr = (const f32x4*)xrow + lane; const f32x4* gr = (const f32x4*)g + lane;
    f32x4 v[8]; float s = 0.f;
#pragma unroll
    for (int j = 0; j < 8; ++j) { v[j] = xr[64 * j]; s += (v[j].x * v[j].x + v[j].y * v[j].y) + (v[j].z * v[j].z + v[j].w * v[j].w); }
    const float rinv = 1.f / sqrtf(wave_sum(s) * (1.f / DM) + EPS);
    v2u* o8 = (v2u*)orow + lane;
#pragma unroll
    for (int j = 0; j < 8; ++j) { const f32x4 gg = gr[64 * j]; v2u w; w.x = pk2(v[j].x * rinv * gg.x, v[j].y * rinv * gg.y); w.y = pk2(v[j].z * rinv * gg.z, v[j].w * rinv * gg.w); o8[64 * j] = w; }
}
template <bool HIN_F32, bool HOUT_F32>
__device__ __forceinline__ void resid_row(const void* __restrict__ hin, const bf16* __restrict__ y  , const float* __restrict__ gpost, const float* __restrict__ gpre,
                                          void* __restrict__ hout, bf16* __restrict__ hn, int lane) {
    const v2u* yr = (const v2u*)y + lane; const f32x4* gp = (const f32x4*)gpost + lane;
    f32x4 v[8], hh[8]; float s = 0.f;
#pragma unroll
    for (int j = 0; j < 8; ++j) { const v2u w = yr[64 * j]; v[j] = (f32x4){bf_lo(w.x), bf_hi(w.x), bf_lo(w.y), bf_hi(w.y)}; }
    if constexpr (HIN_F32) { const f32x4* hr = (const f32x4*)hin + lane;
#pragma unroll
        for (int j = 0; j < 8; ++j) hh[j] = hr[64 * j];
    } else { const v2u* hr = (const v2u*)hin + lane;
#pragma unroll
        for (int j = 0; j < 8; ++j) { const v2u w = hr[64 * j]; hh[j] = (f32x4){bf_lo(w.x), bf_hi(w.x), bf_lo(w.y), bf_hi(w.y)}; }
    }
#pragma unroll
    for (int j = 0; j < 8; ++j) s += (v[j].x * v[j].x + v[j].y * v[j].y) + (v[j].z * v[j].z + v[j].w * v[j].w);
    const float rinv = 1.f / sqrtf(wave_sum(s) * (1.f / DM) + EPS);
    float s2 = 0.f;
#pragma unroll
    for (int j = 0; j < 8; ++j) { const f32x4 gg = gp[64 * j];
        v[j] = hh[j] + (v[j] * rinv) * gg;
        if constexpr (HOUT_F32) ((f32x4*)hout + lane)[64 * j] = v[j];
        else { v2u w; w.x = pk2(v[j].x, v[j].y); w.y = pk2(v[j].z, v[j].w); ((v2u*)hout + lane)[64 * j] = w; }
        s2 += (v[j].x * v[j].x + v[j].y * v[j].y) + (v[j].z * v[j].z + v[j].w * v[j].w); }
    if (gpre) {
        const float rinv2 = 1.f / sqrtf(wave_sum(s2) * (1.f / DM) + EPS);
        const f32x4* gq = (const f32x4*)gpre + lane; v2u* o8 = (v2u*)hn + lane;
#pragma unroll
        for (int j = 0; j < 8; ++j) { const f32x4 gg = gq[64 * j]; v2u w; w.x = pk2(v[j].x * rinv2 * gg.x, v[j].y * rinv2 * gg.y); w.y = pk2(v[j].z * rinv2 * gg.z, v[j].w * rinv2 * gg.w); o8[64 * j] = w; }
    }
}

template <class Epi>
__device__ __forceinline__ void run_gemm(PG8_LAS unsigned char* lds, int wv, const bf16* A, const bf16* Bt, int M, int N, int K, const Epi& E, int crot = 0  ) {
    pg8::Gemm g{A, Bt, M, N, K}; pg8::StaticOrder S; S.init(M, N, (int)gridDim.x, (int)((blockIdx.x + gridDim.x - (unsigned)crot) % gridDim.x));
    if (EN_GEMM && (EN_EPI < 0 || EN_EPI == Epi::ID)) pg8::gemm_phase<Epi, pg8::StaticOrder, true, true>(lds, g, S, E, wv);
}
template <bool HIN_F32, bool HOUT_F32>
__device__ __forceinline__ void resid_phase(int wv, const void* hin, const bf16* y, const float* gpost, const float* gpre, void* hout, bf16* hn) {
    const int tid = opaque_tid(wv), lane = tid & 63, gw = blockIdx.x * NWAVES + (tid >> 6), NGW = gridDim.x * NWAVES;
    constexpr size_t SIN = HIN_F32 ? 4 : 2, SOUT = HOUT_F32 ? 4 : 2;
    for (int m = gw; m < S_; m += NGW) resid_row<HIN_F32, HOUT_F32>((const char*)hin + (size_t)m * DM * SIN, y + (size_t)m * DM, gpost, gpre, (char*)hout + (size_t)m * DM * SOUT, hn + (size_t)m * DM, lane);
}
#define XB_TMO      128
#define XB_XCNT(j)  (256  + 64 * (j))
#define XB_XSUB(j)  (1280 + 64 * (j))
#define XB_XGEN(j)  (2304 + 64 * (j))
#define XB_TOP      3328
#define XB_TOPGEN   3392
#define XCD_BAR_WORDS 3456
#define XB_SPIN_CAP (1u << 18)

__device__ __forceinline__ unsigned xb_ld(unsigned* p)              { return __hip_atomic_load(p, __ATOMIC_RELAXED, __HIP_MEMORY_SCOPE_AGENT); }
__device__ __forceinline__ unsigned xb_add(unsigned* p, unsigned v) { return __hip_atomic_fetch_add(p, v, __ATOMIC_RELAXED, __HIP_MEMORY_SCOPE_AGENT); }
__device__ __forceinline__ unsigned xb_xcc_id() { return (unsigned)__builtin_amdgcn_s_getreg((3 << 11) | 20) & 0xFu; }
#define XB_SPIN(cond, bar) do { unsigned _sp = 0; while (cond) { __builtin_amdgcn_s_sleep(1); \
    if ((++_sp & 255u) == 0u) { if (xb_ld(&(bar)[XB_TMO])) break; if (_sp > XB_SPIN_CAP) { atomicAdd(&(bar)[XB_TMO], 1u); break; } } } } while (0)

struct XcdBarrier {
    unsigned* bar; unsigned x;
    volatile LAS unsigned* st;
};

__device__ __forceinline__ XcdBarrier xcd_barrier_post(unsigned* bar, volatile LAS unsigned* st) {
    XcdBarrier b; b.bar = bar; b.x = xb_xcc_id(); b.st = st;
    if (threadIdx.x == 0) (void)xb_add(&bar[XB_XCNT(b.x)], 1u);
    return b;
}
__device__ __forceinline__ void xcd_barrier_complete(unsigned* bar, unsigned x, unsigned& nloc, unsigned& nx) {
    const unsigned G = gridDim.x * gridDim.y * gridDim.z;
    unsigned sum, cnt, mine, sp = 0u;
    for (;;) {
        sum = 0u; cnt = 0u; mine = 0u;
#pragma unroll
        for (unsigned j = 0; j < 16; ++j) { const unsigned c = xb_ld(&bar[XB_XCNT(j)]); sum += c; cnt += (c > 0u) ? 1u : 0u; mine = (j == x) ? c : mine; }
        if (sum == G) break;
        __builtin_amdgcn_s_sleep(1);
        if ((++sp & 255u) == 0u) { if (xb_ld(&bar[XB_TMO])) break; if (sp > XB_SPIN_CAP) { atomicAdd(&bar[XB_TMO], 1u); break; } }
    }
    nloc = mine > 0u ? mine : 1u; nx = cnt > 0u ? cnt : 1u;
}

__device__ __forceinline__ void xcd_barrier(const XcdBarrier& b, bool leader) {
    asm volatile("s_waitcnt vmcnt(0)" ::: "memory");
    __syncthreads();
    if (leader) {
        unsigned* bar = b.bar;
        __builtin_amdgcn_s_waitcnt(0);
        unsigned nloc = b.st[0], nx = b.st[1];
        if (nloc == 0u) { xcd_barrier_complete(bar, b.x, nloc, nx); b.st[0] = nloc; b.st[1] = nx; }
        const unsigned old = xb_add(&bar[XB_XSUB(b.x)], 1u);
        const unsigned gen = old / nloc;
        if (old + 1u == (gen + 1u) * nloc) {
            __builtin_amdgcn_fence(__ATOMIC_RELEASE, "agent");
            asm volatile("s_waitcnt vmcnt(0)" ::: "memory");
            const unsigned og = xb_add(&bar[XB_TOP], 1u);
            const unsigned tg = og / nx;
            if (og + 1u == (tg + 1u) * nx) xb_add(&bar[XB_TOPGEN], 1u);
            else XB_SPIN(xb_ld(&bar[XB_TOPGEN]) == tg, bar);
            __builtin_amdgcn_fence(__ATOMIC_ACQUIRE, "agent");
            xb_add(&bar[XB_XGEN(b.x)], 1u);
            asm volatile("s_waitcnt vmcnt(0)" ::: "memory");
        } else {
            XB_SPIN(xb_ld(&bar[XB_XGEN(b.x)]) == gen, bar);
            __builtin_amdgcn_fence(__ATOMIC_ACQUIRE, "agent");
            asm volatile("s_waitcnt vmcnt(0)" ::: "memory");
        }
    }
    __syncthreads();
}

__global__ void __launch_bounds__(NTHREADS, 2) fwd_megakernel(Params P) {
    extern __shared__ __attribute__((aligned(16))) unsigned char lds[];
    cg::grid_group grid = cg::this_grid();
    const int wave_s = __builtin_amdgcn_readfirstlane((int)threadIdx.x >> 6);
    {
        volatile LAS unsigned* misc0 = (volatile LAS unsigned*)((LAS unsigned char*)lds + MISC_OFF);
        if (threadIdx.x < 16) misc0[threadIdx.x] = 0u;
        __syncthreads();
        (void)xcd_barrier_post((unsigned*)(kp()->ws + WS_CTL), misc0 + 8);
    }
#define SLOT_BEGIN(c0_) { int gqs_ = (int)gridDim.x; asm volatile("" : "+s"(gqs_)); const int c0s_ = (gqs_ == 256) ? (c0_) : 0; if (bx >= c0s_) { PHASE_IDS(); LAS float* scr = (LAS float*)(ldsp + wave * 16384); const int gws = (bx - c0s_) * NWAVES + wave, NGWS = (gqs_ - c0s_) * NWAVES; int base = 0; (void)gw;
#define SLOT_T(W_, K_, N_, WT_, LDK_) transpose_matrix(W_, K_, N_, WT_, 0, scr, gws, NGWS, lane, base, LDK_)
#define SLOT_END() } }
#define GSYNC() do { XcdBarrier b_; b_.bar = (unsigned*)(kp()->ws + WS_CTL); b_.x = xb_xcc_id(); b_.st = (volatile LAS unsigned*)((LAS unsigned char*)lds + MISC_OFF) + 8; xcd_barrier(b_, opaque_tid(wave_s) == 0); } while (0)
    PG8_LAS unsigned char* ldsp = (PG8_LAS unsigned char*)lds;
    const int G = gridDim.x, bx = blockIdx.x, NGW = G * NWAVES;
#define PHASE_IDS() const int tid = opaque_tid(wave_s), lane = tid & 63, wave = __builtin_amdgcn_readfirstlane(tid >> 6), gw = bx * NWAVES + wave; (void)lane; (void)gw
#define WSB (kp()->ws)
#define X_IN (kp()->in[0])
#define MEM_IN (kp()->in[1])
#define Win_t0 ((bf16*)(WSB + WS_WIN0))
#define Win_t1 ((bf16*)(WSB + WS_WIN1))
#define Wout_t0 ((bf16*)(WSB + WS_WOUT0))
#define Wout_t1 ((bf16*)(WSB + WS_WOUT1))
#define MEMN ((bf16*)(WSB + WS_MEMN))
#define KVM ((bf16*)(WSB + WS_KVM))
#define ROPE ((float*)(WSB + WS_ROPE))
#define HN ((bf16*)(WSB + WS_HN))
#define YC ((bf16*)(WSB + WS_YC))
#define Y_BUF ((bf16*)(WSB + WS_Y))
#define PROJ ((bf16*)(WSB + WS_PROJ))
#define OD ((bf16*)(WSB + WS_OD))
#define U_BUF ((bf16*)(WSB + WS_U))
#define QM ((bf16*)(WSB + WS_QM))
#define OM ((bf16*)(WSB + WS_OM))
#define H_BUF (kp()->out)
#define HB_BUF ((bf16*)(WSB + WS_Y + 32 * MiB))
    for (int rep_ = 0; rep_ < (PROBE == 1 ? 2 : 1); ++rep_) {
        PHASE_IDS();
        LAS float* scr = (LAS float*)(ldsp + wave * 16384);
        int base = 0;
        transpose_matrix(kp()->in[2], DM, EVEN_IN, Win_t0, 0, scr, gw, NGW, lane, base);
        for (int l = 0; l < 2; ++l) {
            transpose_matrix(kp()->in[19] + (size_t)l * DM * MEMW, DM, MEMW, (bf16*)(WSB + WS_WKV + l * 4 * MiB), 0, scr, gw, NGW, lane, base);
            transpose_matrix(kp()->in[20] + (size_t)l * DM * MEMW, DM, MEMW, (bf16*)(WSB + WS_WKV + l * 4 * MiB), MEMW, scr, gw, NGW, lane, base);
        }
        for (int i = bx * NTHREADS + tid; i < S_ * 16; i += G * NTHREADS) {
            const int pos = i >> 4, k = i & 15;
            const float inv = (float)exp2(-(double)k * (18.931568569324174 / 16.0));
            const float ang = (float)pos * inv;
            double t = (double)ang * 0.15915494309189535; t -= rint(t);
            const float fr = (float)t;
            ROPE[2 * i] = __builtin_amdgcn_cosf(fr); ROPE[2 * i + 1] = __builtin_amdgcn_sinf(fr);
        }
        for (int m = gw; m < 2 * MEMLEN; m += NGW) { const int l = m / MEMLEN, r = m % MEMLEN;
            rms_row_bf16(MEM_IN + (size_t)r * DM, kp()->in[15] + l * DM, MEMN + (size_t)m * DM, lane); }
        for (int m = gw; m < S_; m += NGW) rms_row_bf16(X_IN + (size_t)m * DM, kp()->in[13], HN + (size_t)m * DM, lane);
    }
    if (gridDim.x == 0x7fffffffu) grid.sync();
    GSYNC();

    for (int layer = 0; layer < 2; ++layer) {

        if (layer == 0) {
            run_gemm(ldsp, wave_s, HN, Win_t0, S_, EVEN_IN, DM, pg8::EpiBf16Rope{PROJ, EVEN_IN, ROPE, 24, 34});
            for (int l = 0; l < 2; ++l)
                run_gemm(ldsp, wave_s, MEMN + (size_t)l * MEMLEN * DM, (const bf16*)(WSB + WS_WKV + l * 4 * MiB), MEMLEN, 2 * MEMW, DM, pg8::EpiBf16<0>{KVM + (size_t)l * MEMLEN * 2 * MEMW, 2 * MEMW}, 64 + 4 * l);
            SLOT_BEGIN(64)
                SLOT_T(kp()->in[3], DM, DM, Wout_t0, 0);
                SLOT_T(kp()->in[18], DM, MEMW, (bf16*)(WSB + WS_WQ), 0);
                SLOT_T(kp()->in[21], MEMW, DM, (bf16*)(WSB + WS_WO), 0);
                SLOT_T(kp()->in[24], DM, DFF, (bf16*)(WSB + WS_WUP), 0);
                SLOT_T(kp()->in[25], DFF, DM, (bf16*)(WSB + WS_WDN), 0);
            SLOT_END()
        } else {
            run_gemm(ldsp, wave_s, HN, Win_t1, S_, ODD_IN, DM, pg8::EpiBf16Rope{PROJ, ODD_IN, ROPE, 0, 32});
        }
        GSYNC();
        if (layer == 0) {
            PHASE_IDS();
            const int r32 = lane & 31, hi = lane >> 5;
            for (int u = bx; u < 512; u += G) {
                const int kind = u >> 8, uu = u & 255, hd = uu & 7, qb = uu >> 3;
                if (kind == 0) {
                    LAS float* tab = (LAS float*)(ldsp + NA_TAB_OFF);
                    __syncthreads();
                    if (tid < 465) tab[tid] = kp()->in[4][hd * 465 + tid] * (1.f / att::SCALE);
                    __syncthreads();
                    const int i0 = 4 * qb, kr0 = min(max(i0 - 4, 0), 120), thi = min(max(i0 - 1, 0), 120) + 7;
                    int NT = thi - kr0 + 1; NT += NT & 1;
                    const int qi = i0 + (wave >> 1), qj = 32 * (wave & 1) + r32;
                    att::ModNA mod{kr0, qi, qj, min(max(qi - 4, 0), 120), min(max(qj - 8, 0), 48), hi, tab};
                    if (EN_NA) att::attn_body<EVEN_IN, EVEN_IN, DM, att::ModNA>(PROJ + (size_t)(256 * qb) * EVEN_IN + hd * 128, PROJ + (size_t)(kr0 * 64) * EVEN_IN + 1024 + hd * 128,
                        PROJ + (size_t)(kr0 * 64) * EVEN_IN + 2048 + hd * 128, YC + (size_t)(256 * qb) * DM + hd * 128, NT, (char*)lds, wave_s, mod, -1e30f, 0.f);
                } else {
                    const int q0 = 256 * qb, ks = max(q0 - 128, 0), ke = min(q0 + 384, S_), NT = (ke - ks) / 64, kvh = hd >> 2;
                    att::ModSWA mod{q0 + wave * 32 + r32 - ks, hi};
                    const float sink = kp()->in[5][hd];
                    if (EN_SWA) att::attn_body<EVEN_IN, EVEN_IN, DM, att::ModSWA>(PROJ + (size_t)q0 * EVEN_IN + 3072 + hd * 128, PROJ + (size_t)ks * EVEN_IN + 4096 + kvh * 128,
                        PROJ + (size_t)ks * EVEN_IN + 4352 + kvh * 128, YC + (size_t)q0 * DM + 1024 + hd * 128, NT, (char*)lds, wave_s, mod, sink * (1.f / att::SCALE), 1.f);
                }
            }
        } else {
            for (int rep_ = 0; rep_ < (PROBE == 2 ? 2 : 1); ++rep_)
            for (int u = bx; u < 1024; u += G) {
                const int i = u >> 8, c = u & 255, combo = 2 * (c & 7) + (i >> 1), qb = (i & 1) * 32 + (c >> 3);
                const int h = combo >> 1;
                if (EN_DIFF) att::attn_dv256_body<ODD_IN, ODD_IN, ODD_IN, 4096>(PROJ + (size_t)(128 * qb) * ODD_IN + combo * 128, PROJ + 2048 + combo * 128,
                    PROJ + 4096 + h * 256, OD + (size_t)(128 * qb) * 4096 + combo * 256, S_ / 64, (char*)lds, wave_s);
            }
            if (G == 256) { asm volatile("s_waitcnt vmcnt(0)" ::: "memory"); __syncthreads(); } else GSYNC();
            {
                PHASE_IDS();
                const float a1 = kp()->in[8][lane] * kp()->in[9][lane] + kp()->in[8][lane + 64] * kp()->in[9][lane + 64];
                const float a2 = kp()->in[10][lane] * kp()->in[11][lane] + kp()->in[10][lane + 64] * kp()->in[11][lane + 64];
                const float lam = expf(wave_sum(a1)) - expf(wave_sum(a2)) + LAMBDA_INIT1;
                const f32x4 gg = ((const f32x4*)kp()->in[12])[lane];
                const int nit = (G == 256) ? 256 : S_ * 8;
                for (int it = (G == 256) ? wave : gw; it < nit; it += (G == 256) ? NWAVES : NGW) {
                    const int row = (G == 256) ? 128 * ((it >> 7) * 32 + (bx >> 3)) + (it & 127) : it >> 3, h = (G == 256) ? (bx & 7) : it & 7;
                    const v2u o0 = *((const v2u*)(OD + (size_t)row * 4096 + (h * 2) * 256) + lane), o1 = *((const v2u*)(OD + (size_t)row * 4096 + (h * 2 + 1) * 256) + lane);
                    f32x4 d; d.x = bf_lo(o0.x) - lam * bf_lo(o1.x); d.y = bf_hi(o0.x) - lam * bf_hi(o1.x); d.z = bf_lo(o0.y) - lam * bf_lo(o1.y); d.w = bf_hi(o0.y) - lam * bf_hi(o1.y);
                    const float ss = wave_sum((d.x * d.x + d.y * d.y) + (d.z * d.z + d.w * d.w));
                    const float rinv = (1.f - LAMBDA_INIT1) / sqrtf(ss * (1.f / 256.f) + EPS);
                    v2u w; w.x = pk2(d.x * rinv * gg.x, d.y * rinv * gg.y); w.y = pk2(d.z * rinv * gg.z, d.w * rinv * gg.w);
                    *((v2u*)(YC + (size_t)row * DM + h * 256) + lane) = w;
                }
            }
        }
        GSYNC();
        run_gemm(ldsp, wave_s, YC, (layer == 0 ? Wout_t0 : Wout_t1), S_, DM, DM, pg8::EpiBf16<0>{Y_BUF, DM});
        GSYNC();
        if (layer == 0) resid_phase<true, false>(wave_s, X_IN, Y_BUF, kp()->in[14], kp()->in[16], HB_BUF, HN);
        else resid_phase<false, false>(wave_s, HB_BUF, Y_BUF, kp()->in[14] + DM, kp()->in[16] + DM, HB_BUF, HN);
        GSYNC();
        run_gemm(ldsp, wave_s, HN, (const bf16*)(WSB + WS_WQ + layer * 2 * MiB), S_, MEMW, DM, pg8::EpiBf16<0>{QM, MEMW});
        if (layer == 0) {
            SLOT_BEGIN(64)
                SLOT_T(kp()->in[6], DM, ODD_IN, Win_t1, 0);
                SLOT_T(kp()->in[7], DM, DM, Wout_t1, 0);
                SLOT_T(kp()->in[18] + (size_t)DM * MEMW, DM, MEMW, (bf16*)(WSB + WS_WQ + 2 * MiB), 0);
                SLOT_T(kp()->in[21] + (size_t)MEMW * DM, MEMW, DM, (bf16*)(WSB + WS_WO + 2 * MiB), 0);
                SLOT_T(kp()->in[24] + (size_t)DM * DFF, DM / 2, DFF, (bf16*)(WSB + WS_WUP + 32 * MiB), DM);
            SLOT_END()
        } else {
            SLOT_BEGIN(64)
                SLOT_T(kp()->in[24] + (size_t)DM * DFF + (size_t)(DM / 2) * DFF, DM / 2, DFF, (bf16*)(WSB + WS_WUP + 32 * MiB) + DM / 2, DM);
                SLOT_T(kp()->in[25] + (size_t)DFF * DM, DFF, DM, (bf16*)(WSB + WS_WDN + 32 * MiB), 0);
            SLOT_END()
        }
        GSYNC();
        for (int u = bx; u < 128; u += G) {
            const int hd = u & 3, qb = u >> 2; const bf16* kv = KVM + (size_t)layer * MEMLEN * 2 * MEMW;
            if (EN_MEM) att::attn_body<MEMW, 2 * MEMW, MEMW, att::ModNone>(QM + (size_t)(256 * qb) * MEMW + hd * 128, kv + hd * 128, kv + MEMW + hd * 128,
                OM + (size_t)(256 * qb) * MEMW + hd * 128, MEMLEN / 64, (char*)lds, wave_s, att::ModNone{}, -1e30f, 0.f);
        }
        GSYNC();
        run_gemm(ldsp, wave_s, OM, (const bf16*)(WSB + WS_WO + layer * 2 * MiB), S_, DM, MEMW, pg8::EpiBf16<0>{Y_BUF, DM});
        GSYNC();
        resid_phase<false, false>(wave_s, HB_BUF, Y_BUF, kp()->in[17] + layer * DM, kp()->in[22] + layer * DM, HB_BUF, HN);
        GSYNC();
        for (int rep_ = 0; rep_ < ((PROBE == 3 && layer == 0) ? 2 : 1); ++rep_) {
        run_gemm(ldsp, wave_s, HN, (const bf16*)(WSB + WS_WUP + layer * 32 * MiB), S_, DFF, DM, pg8::EpiBf16<1>{U_BUF, DFF});
        GSYNC();
        run_gemm(ldsp, wave_s, U_BUF, (const bf16*)(WSB + WS_WDN + layer * 32 * MiB), S_, DM, DFF, pg8::EpiBf16<0>{Y_BUF, DM});
        GSYNC();
        }
        if (layer == 0) resid_phase<false, false>(wave_s, HB_BUF, Y_BUF, kp()->in[23], kp()->in[13] + DM, HB_BUF, HN);
        else resid_phase<false, true>(wave_s, HB_BUF, Y_BUF, kp()->in[23] + DM, nullptr, H_BUF, HN);
        if (layer == 0) GSYNC();
    }
}

extern "C" void kernel_launch(void* const* d_in, const int* in_sizes, int n_in, void* d_out, int out_size, void* d_ws, size_t ws_size, hipStream_t stream) {
    static int grid = 0;
    if (grid == 0) {
        if (n_in != 26 || out_size != S_ * DM || ws_size < WS_END) { fprintf(stderr, "kernel_launch: unexpected shapes: n_in %d out %d ws %zu (need %zu)\n", n_in, out_size, ws_size, (size_t)WS_END); grid = -1; return; }
        int dev = 0, cus = 0, per_cu = 0;
        hipGetDevice(&dev); hipDeviceGetAttribute(&cus, hipDeviceAttributeMultiprocessorCount, dev);
        if (hipFuncSetAttribute((const void*)fwd_megakernel, hipFuncAttributeMaxDynamicSharedMemorySize, LDS_BYTES) != hipSuccess) { fprintf(stderr, "kernel_launch: hipFuncSetAttribute failed\n"); grid = -1; return; }
        if (hipOccupancyMaxActiveBlocksPerMultiprocessor(&per_cu, (const void*)fwd_megakernel, NTHREADS, LDS_BYTES) != hipSuccess || per_cu < 1) { fprintf(stderr, "kernel_launch: occupancy query says %d\n", per_cu); per_cu = 1; }
        (void)hipGetLastError();
        grid = cus;
        if (grid != 256) fprintf(stderr, "kernel_launch: %d CUs (expected 256)\n", grid);
    }
    if (grid < 0) return;
    if (hipMemsetAsync((char*)d_ws + WS_CTL, 0, CTL_ZERO_BYTES, stream) != hipSuccess) { fprintf(stderr, "kernel_launch: memset failed\n"); return; }
    Params p{};
    for (int i = 0; i < 26; ++i) p.in[i] = (const float*)d_in[i];
    p.out = (float*)d_out; p.ws = (unsigned char*)d_ws;
    void* args[] = {&p};
    hipError_t e = hipLaunchCooperativeKernel((const void*)fwd_megakernel, dim3(grid), dim3(NTHREADS), args, LDS_BYTES, stream);
    if (e != hipSuccess) fprintf(stderr, "kernel_launch: cooperative launch failed: %s (grid %d)\n", hipGetErrorString(e), grid);
}
```

```cpp
#include <hip/hip_runtime.h>
#include <hip/hip_cooperative_groups.h>
#include <cstdio>
#include <cstdint>
namespace cg = cooperative_groups;
__device__ __forceinline__ int opaque_tid(int wv) { int t; asm volatile("v_mbcnt_lo_u32_b32 %0, -1, 0\n\tv_mbcnt_hi_u32_b32 %0, -1, %0\n\tv_lshl_add_u32 %0, %1, 6, %0" : "=&v"(t) : "s"(wv)); return t; }

namespace pg8 {
#define PG8_LAS __attribute__((address_space(3)))
typedef unsigned short bf16_t;
typedef short bf16x8 __attribute__((ext_vector_type(8)));
typedef float f32x4 __attribute__((ext_vector_type(4)));
typedef unsigned u32x4 __attribute__((ext_vector_type(4)));
constexpr int BM = 256, BK = 64, HALF = 128, HTB = HALF * BK * 2  , STAGE_BYTES = 8 * HTB, NXCD = 8, WGM = 4;

__host__ __device__ __forceinline__ int lds_byte(int r, int c) { const int st = (r >> 4) * 2 + (c >> 5), rr = r & 15, cc = c & 31, ob = rr * 64 + cc * 2; return st * 1024 + (ob ^ (((ob >> 9) & 1) << 5)); }
__host__ __device__ __forceinline__ void stage_rc(int b, int& R, int& C) { const int st = b / 1024, sb = b % 1024, swz = sb ^ (((sb >> 9) & 1) << 5); R = (st >> 1) * 16 + swz / 64; C = (st & 1) * 32 + (swz % 64) / 2; }
__host__ __device__ __forceinline__ int perm32(int rho) { const int n = rho >> 4, i = rho & 15; return 8 * (i >> 2) + 4 * n + (i & 3); }

struct Unit { int pm, pn; };
struct Gemm { const bf16_t* A; const bf16_t* Bt; int M, N, K; };

struct StaticOrder {
    int nM, nN, nwg, G, c;
    __host__ __device__ void init(int M, int N, int G_, int c_) { nM = M / BM; nN = N / BM; nwg = nM * nN; G = G_; c = c_; }
    __host__ __device__ bool next(int i, Unit& u) const {
        const long L = (long)i * G + c; if (L >= nwg) return false;
        int wgid = (int)L; { const int q = nwg / NXCD, r = nwg % NXCD, xcd = wgid % NXCD, off = wgid / NXCD; wgid = (xcd < r ? xcd * (q + 1) : r * (q + 1) + (xcd - r) * q) + off; }
        const int nig = WGM * nN, gid = wgid / nig, fm = gid * WGM, gsz = (nM - fm) < WGM ? (nM - fm) : WGM;
        u.pm = fm + ((wgid % nig) % gsz); u.pn = (wgid % nig) / gsz; return true;
    }
    __device__ __forceinline__ void a_ready(const Unit&) const {}
    __device__ __forceinline__ void done(const Unit&) const {}
};

__device__ __forceinline__ unsigned cvt_pk_bf16(float lo, float hi) { unsigned r; asm volatile("v_cvt_pk_bf16_f32 %0, %1, %2" : "=v"(r) : "v"(lo), "v"(hi)); return r; }
struct EpiF32 {
    static constexpr int ID = 2; static constexpr bool PERM = false, AFTER_DRAIN = false;
    float* C; int ldc;
    __device__ __forceinline__ void operator()(const f32x4 (&acc)[2][2][4][2], const Unit& u, int wr, int wc, int fr, int fq) const {
        const int row0 = u.pm * BM + wr * 64 + fr, col0 = u.pn * BM + wc * 32 + 4 * fq;
#pragma unroll
        for (int ai = 0; ai < 2; ++ai)
#pragma unroll
            for (int m = 0; m < 4; ++m) { float* rowp = C + (size_t)(row0 + ai * HALF + m * 16) * ldc + col0;
#pragma unroll
                for (int bj = 0; bj < 2; ++bj)
#pragma unroll
                    for (int n = 0; n < 2; ++n) *(f32x4*)(rowp + bj * HALF + n * 16) = acc[ai][bj][m][n]; }
    }
    __device__ __forceinline__ void fused(f32x4 (&)[2][2][4][2], const Unit&, int, int, int, int, PG8_LAS unsigned char*, int, int) const {}
};
template <int ACT  > struct EpiBf16 {
    static constexpr int ID = ACT; static constexpr bool PERM = true, AFTER_DRAIN = false;
    bf16_t* O; int ldc;
    __device__ __forceinline__ void operator()(const f32x4 (&acc)[2][2][4][2], const Unit& u, int wr, int wc, int fr, int fq) const {
        const int row0 = u.pm * BM + wr * 64 + fr; const int col0 = u.pn * BM + wc * 32 + 8 * fq;
#pragma unroll
        for (int ai = 0; ai < 2; ++ai)
#pragma unroll
            for (int m = 0; m < 4; ++m) { bf16_t* rowp = O + (size_t)(row0 + ai * HALF + m * 16) * ldc + col0;
#pragma unroll
                for (int bj = 0; bj < 2; ++bj) { f32x4 v0 = acc[ai][bj][m][0], v1 = acc[ai][bj][m][1];
                    if (ACT == 1) {
#pragma unroll
                        for (int j = 0; j < 4; ++j) { const float a = fmaxf(v0[j], 0.f), b = fmaxf(v1[j], 0.f); v0[j] = a * a; v1[j] = b * b; } }
                    u32x4 w; w.x = cvt_pk_bf16(v0[0], v0[1]); w.y = cvt_pk_bf16(v0[2], v0[3]); w.z = cvt_pk_bf16(v1[0], v1[1]); w.w = cvt_pk_bf16(v1[2], v1[3]);
                    *(u32x4*)(rowp + bj * HALF) = w; } }
    }
    __device__ __forceinline__ void fused(f32x4 (&)[2][2][4][2], const Unit&, int, int, int, int, PG8_LAS unsigned char*, int, int) const {}
};

struct EpiBf16Rope {
    static constexpr int ID = 0; static constexpr bool PERM = true, AFTER_DRAIN = false;
    bf16_t* O; int ldc; const float* rope; int head_lo, head_hi;
    __device__ __forceinline__ static float rot(float x, float c, float s, int hi) {
        auto rr = __builtin_amdgcn_permlane32_swap(__float_as_uint(x), __float_as_uint(x), false, false);
        const float y = __uint_as_float(hi ? rr[0] : rr[1]);
        return x * c + y * (hi ? s : -s);
    }
    __device__ __forceinline__ void operator()(const f32x4 (&acc)[2][2][4][2], const Unit& u, int wr, int wc, int fr, int fq) const {
        const int row0 = u.pm * BM + wr * 64 + fr; const int col0 = u.pn * BM + wc * 32 + 8 * fq;
        const int h0 = 2 * u.pn, h1 = h0 + 1, hi = fq >> 1;
        const bool r0 = (wc == 0) && h0 >= head_lo && h0 < head_hi, r1 = (wc == 0) && h1 >= head_lo && h1 < head_hi;
#pragma unroll
        for (int ai = 0; ai < 2; ++ai)
#pragma unroll
            for (int m = 0; m < 4; ++m) { const int row = row0 + ai * HALF + m * 16; bf16_t* rowp = O + (size_t)row * ldc + col0;
                const f32x4* tp = (const f32x4*)(rope + ((size_t)row * 16 + 8 * (fq & 1)) * 2);
#pragma unroll
                for (int bj = 0; bj < 2; ++bj) { f32x4 v0 = acc[ai][bj][m][0], v1 = acc[ai][bj][m][1];
                    if (bj == 0 ? r0 : r1) {
                        { const f32x4 t0 = tp[0], t1 = tp[1];
                          v0[0] = rot(v0[0], t0[0], t0[1], hi); v0[1] = rot(v0[1], t0[2], t0[3], hi); v0[2] = rot(v0[2], t1[0], t1[1], hi); v0[3] = rot(v0[3], t1[2], t1[3], hi); }
                        { const f32x4 t2 = tp[2], t3 = tp[3];
                          v1[0] = rot(v1[0], t2[0], t2[1], hi); v1[1] = rot(v1[1], t2[2], t2[3], hi); v1[2] = rot(v1[2], t3[0], t3[1], hi); v1[3] = rot(v1[3], t3[2], t3[3], hi); } }
                    u32x4 w; w.x = cvt_pk_bf16(v0[0], v0[1]); w.y = cvt_pk_bf16(v0[2], v0[3]); w.z = cvt_pk_bf16(v1[0], v1[1]); w.w = cvt_pk_bf16(v1[2], v1[3]);
                    *(u32x4*)(rowp + bj * HALF) = w; } }
    }
};

template <class Epi, class Sched, bool ALIGN_EPI = false, bool SP2 = false>
__device__ __forceinline__ void gemm_phase(PG8_LAS unsigned char* lds, const Gemm g, const Sched& S, const Epi& E, int wv) {
    const int tid = opaque_tid(wv), wid = __builtin_amdgcn_readfirstlane(tid >> 6), lane = tid & 63, wr = wid >> 2, wc = wid & 3, fr = lane & 15, fq = lane >> 4;
    const int K = g.K, nt = K / BK;
    unsigned voffA[2], voffB[2];
#pragma unroll
    for (int i = 0; i < 2; ++i) { int R, C; stage_rc(tid * 16 + i * 8192, R, C); const int Rb = Epi::PERM ? ((R & ~31) + perm32(R & 31)) : R;
        voffA[i] = (unsigned)(R * K + C) * 2u; voffB[i] = (unsigned)(Rb * K + C) * 2u; }
    const size_t kstep = (size_t)(BK * 2);
    const size_t hstep = (size_t)HALF * K * 2;
    const size_t tstep = 2 * hstep;
    const unsigned ldsw = (unsigned)wid * 1024u;
    const int aoff = lds_byte(wr * 64 + fr, fq * 8), boff = lds_byte(wc * 32 + fr, fq * 8);
#define PG8_SA(b, h) (((b) * 2 + (h)) * HTB)
#define PG8_SB(b, h) ((4 + (b) * 2 + (h)) * HTB)
#define PG8_STAGE(bufoff, gbase, voff) do { _Pragma("unroll") for (int _i = 0; _i < 2; ++_i) \
        __builtin_amdgcn_global_load_lds((const unsigned*)((const char*)(gbase) + (voff)[_i]), (PG8_LAS unsigned*)(lds + (bufoff) + ldsw + _i * 8192), 16, 0, 0); } while (0)
#define PG8_LDA(dst, b, h) do { _Pragma("unroll") for (int m = 0; m < 4; ++m) _Pragma("unroll") for (int k = 0; k < 2; ++k) dst[m][k] = *(const PG8_LAS bf16x8*)(lds + PG8_SA(b, h) + aoff + m * 2048 + k * 1024); } while (0)
#define PG8_LDB(dst, b, h) do { _Pragma("unroll") for (int n = 0; n < 2; ++n) _Pragma("unroll") for (int k = 0; k < 2; ++k) dst[n][k] = *(const PG8_LAS bf16x8*)(lds + PG8_SB(b, h) + boff + n * 2048 + k * 1024); } while (0)
#define PG8_MMA(ai, bj, At, Bt) do { __builtin_amdgcn_s_setprio(1); _Pragma("unroll") for (int m = 0; m < 4; ++m) _Pragma("unroll") for (int n = 0; n < 2; ++n) _Pragma("unroll") for (int k = 0; k < 2; ++k) \
        acc[ai][bj][m][n] = __builtin_amdgcn_mfma_f32_16x16x32_bf16(Bt[n][k], At[m][k], acc[ai][bj][m][n], 0, 0, 0); __builtin_amdgcn_s_setprio(0); } while (0)
#define PG8_WAIT_V(n) asm volatile("s_waitcnt vmcnt(" #n ")" ::: "memory")
#define PG8_WAIT_L(n) asm volatile("s_waitcnt lgkmcnt(" #n ")" ::: "memory")
#define PG8_BAR __builtin_amdgcn_s_barrier()
#define PG8_SCHED __builtin_amdgcn_sched_barrier(0)
    Unit cur, nxt; int ui = 0;
    if (!S.next(0, cur)) return;
    f32x4 acc[2][2][4][2];
#pragma unroll
    for (int a = 0; a < 2; ++a)
#pragma unroll
        for (int b = 0; b < 2; ++b)
#pragma unroll
            for (int m = 0; m < 4; ++m)
#pragma unroll
                for (int n = 0; n < 2; ++n) acc[a][b][m][n] = (f32x4){0.f, 0.f, 0.f, 0.f};
    bf16x8 At[4][2], B0[2][2], B1[2][2];
    const char* cA = (const char*)g.A + (size_t)cur.pm * tstep; const char* cB = (const char*)g.Bt + (size_t)cur.pn * tstep;
    S.a_ready(cur);
    if constexpr (SP2) {
        PG8_STAGE(PG8_SB(0, 0), cB, voffB); PG8_STAGE(PG8_SB(0, 1), cB + hstep, voffB); PG8_STAGE(PG8_SA(0, 0), cA, voffA); PG8_STAGE(PG8_SA(0, 1), cA + hstep, voffA);
        if (wr == 1) PG8_BAR;
        PG8_WAIT_V(2); PG8_BAR;
        PG8_STAGE(PG8_SB(1, 0), cB + kstep, voffB); PG8_STAGE(PG8_SA(1, 0), cA + kstep, voffA); PG8_STAGE(PG8_SB(1, 1), cB + hstep + kstep, voffB);
        PG8_WAIT_V(6); PG8_BAR;
    } else {
        PG8_STAGE(PG8_SB(0, 0), cB, voffB); PG8_STAGE(PG8_SA(0, 0), cA, voffA); PG8_STAGE(PG8_SB(0, 1), cB + hstep, voffB); PG8_STAGE(PG8_SA(0, 1), cA + hstep, voffA);
        if (wr == 1) PG8_BAR;
        PG8_WAIT_V(4); PG8_BAR;
        PG8_STAGE(PG8_SB(1, 0), cB + kstep, voffB); PG8_STAGE(PG8_SA(1, 0), cA + kstep, voffA); PG8_STAGE(PG8_SB(1, 1), cB + hstep + kstep, voffB);
        PG8_WAIT_V(6); PG8_BAR;
    }
    for (;;) {
        const bool has_next = S.next(ui + 1, nxt);
        const char* nA = has_next ? (const char*)g.A + (size_t)nxt.pm * tstep : cA; const char* nB = has_next ? (const char*)g.Bt + (size_t)nxt.pn * tstep : cB;
        for (int t = 0; t < nt; t += 2) {
            const bool last = (t == nt - 2);
            const char* a1 = cA + (size_t)(t + 1) * kstep;
            const char* a2 = last ? nA : cA + (size_t)(t + 2) * kstep; const char* b2 = last ? nB : cB + (size_t)(t + 2) * kstep;
            const char* a3 = a2 + kstep; const char* b3 = b2 + kstep;
            if (last && has_next) S.a_ready(nxt);
            if constexpr (SP2) {
            PG8_LDB(B0, 0, 0); PG8_LDB(B1, 0, 1); PG8_SCHED; PG8_LDA(At, 0, 0); PG8_STAGE(PG8_SA(1, 1), a1 + hstep, voffA);
            PG8_WAIT_V(8); PG8_WAIT_L(0); PG8_BAR; PG8_MMA(0, 0, At, B0); PG8_MMA(0, 1, At, B1); PG8_BAR; PG8_SCHED;
            PG8_LDA(At, 0, 1); PG8_STAGE(PG8_SB(0, 0), b2, voffB); PG8_STAGE(PG8_SB(0, 1), b2 + hstep, voffB); PG8_STAGE(PG8_SA(0, 0), a2, voffA);
            PG8_WAIT_V(8); PG8_WAIT_L(0); PG8_BAR; PG8_MMA(1, 0, At, B0); PG8_MMA(1, 1, At, B1); PG8_BAR; PG8_SCHED;
            PG8_LDB(B0, 1, 0); PG8_LDB(B1, 1, 1); PG8_SCHED; PG8_LDA(At, 1, 0); PG8_STAGE(PG8_SA(0, 1), a2 + hstep, voffA);
            PG8_WAIT_V(8); PG8_WAIT_L(0); PG8_BAR; PG8_MMA(0, 0, At, B0); PG8_MMA(0, 1, At, B1); PG8_BAR; PG8_SCHED;
            PG8_LDA(At, 1, 1); PG8_STAGE(PG8_SB(1, 0), b3, voffB); PG8_STAGE(PG8_SB(1, 1), b3 + hstep, voffB); PG8_STAGE(PG8_SA(1, 0), a3, voffA);
            PG8_WAIT_V(8); PG8_WAIT_L(0); PG8_BAR; PG8_MMA(1, 0, At, B0); PG8_MMA(1, 1, At, B1); PG8_BAR; PG8_SCHED;
            } else {
            PG8_LDB(B0, 0, 0); PG8_SCHED; PG8_LDA(At, 0, 0); PG8_STAGE(PG8_SA(1, 1), a1 + hstep, voffA);
            PG8_WAIT_L(8); PG8_BAR; PG8_WAIT_L(0); PG8_MMA(0, 0, At, B0); PG8_BAR; PG8_SCHED;
            PG8_LDB(B1, 0, 1); PG8_STAGE(PG8_SB(0, 0), b2, voffB);
            PG8_BAR; PG8_WAIT_L(0); PG8_MMA(0, 1, At, B1); PG8_BAR;
            PG8_LDA(At, 0, 1); PG8_STAGE(PG8_SA(0, 0), a2, voffA);
            PG8_BAR; PG8_WAIT_L(0); PG8_MMA(1, 0, At, B0); PG8_BAR; PG8_SCHED;
            PG8_STAGE(PG8_SB(0, 1), b2 + hstep, voffB);
            PG8_WAIT_V(6); PG8_BAR; PG8_MMA(1, 1, At, B1); PG8_BAR;
            PG8_LDB(B0, 1, 0); PG8_SCHED; PG8_LDA(At, 1, 0); PG8_STAGE(PG8_SA(0, 1), a2 + hstep, voffA);
            PG8_WAIT_L(8); PG8_BAR; PG8_WAIT_L(0); PG8_MMA(0, 0, At, B0); PG8_BAR; PG8_SCHED;
            PG8_LDB(B1, 1, 1); PG8_STAGE(PG8_SB(1, 0), b3, voffB);
            PG8_BAR; PG8_WAIT_L(0); PG8_MMA(0, 1, At, B1); PG8_BAR;
            PG8_LDA(At, 1, 1); PG8_STAGE(PG8_SA(1, 0), a3, voffA);
            PG8_BAR; PG8_WAIT_L(0); PG8_MMA(1, 0, At, B0); PG8_BAR; PG8_SCHED;
            PG8_STAGE(PG8_SB(1, 1), b3 + hstep, voffB);
            PG8_WAIT_V(6); PG8_BAR; PG8_MMA(1, 1, At, B1); PG8_BAR;
            }
        }
        if constexpr (ALIGN_EPI) { if (wr == 0) PG8_BAR; }
        if constexpr (!Epi::AFTER_DRAIN) { E(acc, cur, wr, wc, fr, fq); S.done(cur); }
        if (!has_next) break;
#pragma unroll
        for (int a = 0; a < 2; ++a)
#pragma unroll
            for (int b = 0; b < 2; ++b)
#pragma unroll
                for (int m = 0; m < 4; ++m)
#pragma unroll
                    for (int n = 0; n < 2; ++n) acc[a][b][m][n] = (f32x4){0.f, 0.f, 0.f, 0.f};
        cur = nxt; cA = nA; cB = nB; ++ui;
        if constexpr (ALIGN_EPI) { if (wr == 1) PG8_BAR; }
    }
    PG8_WAIT_V(0);
    if constexpr (!ALIGN_EPI) { if (wr == 0) PG8_BAR; }
    PG8_BAR;
    if constexpr (Epi::AFTER_DRAIN) { E.fused(acc, cur, wr, wc, fr, fq, lds, wid, lane); S.done(cur); }
#undef PG8_SA
#undef PG8_SB
#undef PG8_STAGE
#undef PG8_LDA
#undef PG8_LDB
#undef PG8_MMA
#undef PG8_WAIT_V
#undef PG8_WAIT_L
#undef PG8_BAR
#undef PG8_SCHED
}
}
namespace att {
typedef unsigned short u16;
constexpr int   D = 128, NW = 8, QBLK = 32, KVBLK = 64;
constexpr float SCALE = 0.088388347648318440f;
constexpr float THR = 8.f;
constexpr size_t SHM_V = KVBLK * D * 2, SHM_K = KVBLK * D * 2, SHM_ATTN = 2 * SHM_V + 2 * SHM_K + NW * 64 * 4;
using bf16x8 = __attribute__((ext_vector_type(8))) short;
using s16x4  = __attribute__((ext_vector_type(4))) short;
using f32x16 = __attribute__((ext_vector_type(16))) float;
using u32x4  = __attribute__((ext_vector_type(4))) unsigned;
#define KSWZ(row, colB) ((row) * 256 + ((colB) ^ (((row) & 7) << 4)))
#define SBAR() __builtin_amdgcn_sched_barrier(0)
__device__ __forceinline__ int crow(int r, int hi) { return (r & 3) + 8 * (r >> 2) + 4 * hi; }
__device__ __forceinline__ unsigned cvtpk(float lo, float hi) {
  unsigned r; asm volatile("v_cvt_pk_bf16_f32 %0, %1, %2" : "=v"(r) : "v"(lo), "v"(hi)); return r;
}
__device__ __forceinline__ bf16x8 ld8(const u16* p) { return *reinterpret_cast<const bf16x8*>(p); }

__device__ __forceinline__ void partialSM(f32x16& p0, f32x16& p1, float& m_reg, float& mn, float& alpha) {
  constexpr float C = SCALE * 1.4426950408889634f;
  float pmax = p0[0]; for (int r = 1; r < 16; ++r) pmax = fmaxf(pmax, p0[r]); for (int r = 0; r < 16; ++r) pmax = fmaxf(pmax, p1[r]);
  { auto rr = __builtin_amdgcn_permlane32_swap(__float_as_uint(pmax), __float_as_uint(pmax), false, false);
    pmax = fmaxf(__uint_as_float(rr[0]), __uint_as_float(rr[1])); }
  if (__builtin_expect(__all(pmax - m_reg <= THR / SCALE), 1)) { mn = m_reg; alpha = 1.f; }
  else { mn = fmaxf(m_reg, pmax); alpha = __builtin_amdgcn_exp2f((m_reg - mn) * C); m_reg = mn; }
  float mnC = -mn * C;
  for (int r = 0; r < 16; ++r) p0[r] = fmaf(p0[r], C, mnC); for (int r = 0; r < 16; ++r) p1[r] = fmaf(p1[r], C, mnC);
  for (int r = 0; r < 16; ++r) p0[r] = __builtin_amdgcn_exp2f(p0[r]);
}
__device__ __forceinline__ void finishSM(f32x16& p0, f32x16& p1, float alpha, float& l_reg, bf16x8& pa0, bf16x8& pa1, bf16x8& pa2, bf16x8& pa3) {
  for (int r = 0; r < 16; ++r) p1[r] = __builtin_amdgcn_exp2f(p1[r]);
  float ps = 0; for (int r = 0; r < 16; ++r) ps += p0[r]; for (int r = 0; r < 16; ++r) ps += p1[r];
  { auto rr = __builtin_amdgcn_permlane32_swap(__float_as_uint(ps), __float_as_uint(ps), false, false);
    ps = __uint_as_float(rr[0]) + __uint_as_float(rr[1]); }
  l_reg = l_reg * alpha + ps;
#define PK4(P, BASE, OUT) do { unsigned a0 = cvtpk(P[BASE + 0], P[BASE + 1]), a1 = cvtpk(P[BASE + 2], P[BASE + 3]);   \
    unsigned b0 = cvtpk(P[BASE + 4], P[BASE + 5]), b1 = cvtpk(P[BASE + 6], P[BASE + 7]);                              \
    auto r0 = __builtin_amdgcn_permlane32_swap(a0, b0, false, false); auto r1 = __builtin_amdgcn_permlane32_swap(a1, b1, false, false); \
    u32x4 w = {r0[0], r1[0], r0[1], r1[1]}; OUT = *reinterpret_cast<bf16x8*>(&w); } while (0)
  PK4(p0, 0, pa0); PK4(p0, 8, pa1); PK4(p1, 0, pa2); PK4(p1, 8, pa3);
#undef PK4
}
__device__ __forceinline__ void qkt(f32x16& p0, f32x16& p1, const char* Ks, const bf16x8* qr, int r32, int hi) {
  p0 = f32x16{}; p1 = f32x16{};
  for (int d0 = 0; d0 < 8; ++d0) { int cb = (d0 * 16 + hi * 8) * 2;
    bf16x8 b0 = *reinterpret_cast<const bf16x8*>(Ks + KSWZ(r32, cb));
    bf16x8 b1 = *reinterpret_cast<const bf16x8*>(Ks + KSWZ(32 + r32, cb));
    p0 = __builtin_amdgcn_mfma_f32_32x32x16_bf16(b0, qr[d0], p0, 0, 0, 0);
    p1 = __builtin_amdgcn_mfma_f32_32x32x16_bf16(b1, qr[d0], p1, 0, 0, 0); }
}
__device__ __forceinline__ int v_st(int k, int c) { const int kk = (k & ~0xC) | ((k & 4) << 1) | ((k & 8) >> 1); return ((kk >> 3) * 4 + (c >> 5)) * 512 + ((kk & 7) * 32 + (c & 31)) * 2; }
__device__ __forceinline__ int v_rd_base(int lane) { return ((lane & 3) << 3) | (((lane >> 2) & 3) << 6) | (((lane >> 4) & 1) << 5) | (((lane >> 5) & 1) << 8); }
constexpr int v_rd_off(int d0, int ks, int half) { return d0 * 512 + ks * 4096 + half * 2048; }
template <int OFF> __device__ __forceinline__ s16x4 tr_read(int vb) {
  s16x4 r; asm volatile("ds_read_b64_tr_b16 %0, %1 offset:%2" : "=&v"(r) : "v"(vb), "i"(OFF) : "memory"); return r;
}
template <int D0> __device__ __forceinline__ void pv_one(f32x16& od, int vb, bf16x8 pa0, bf16x8 pa1, bf16x8 pa2, bf16x8 pa3) {
  const s16x4 l0 = tr_read<v_rd_off(D0, 0, 0)>(vb), h0 = tr_read<v_rd_off(D0, 0, 1)>(vb), l1 = tr_read<v_rd_off(D0, 1, 0)>(vb), h1 = tr_read<v_rd_off(D0, 1, 1)>(vb);
  const s16x4 l2 = tr_read<v_rd_off(D0, 2, 0)>(vb), h2 = tr_read<v_rd_off(D0, 2, 1)>(vb), l3 = tr_read<v_rd_off(D0, 3, 0)>(vb), h3 = tr_read<v_rd_off(D0, 3, 1)>(vb);
  asm volatile("s_waitcnt lgkmcnt(0)" ::: "memory"); SBAR();
#define PK(L, H) (bf16x8){L[0], L[1], L[2], L[3], H[0], H[1], H[2], H[3]}
  od = __builtin_amdgcn_mfma_f32_32x32x16_bf16(pa0, PK(l0, h0), od, 0, 0, 0);
  od = __builtin_amdgcn_mfma_f32_32x32x16_bf16(pa1, PK(l1, h1), od, 0, 0, 0);
  od = __builtin_amdgcn_mfma_f32_32x32x16_bf16(pa2, PK(l2, h2), od, 0, 0, 0);
  od = __builtin_amdgcn_mfma_f32_32x32x16_bf16(pa3, PK(l3, h3), od, 0, 0, 0);
#undef PK
}
__device__ __forceinline__ void pv_d0(f32x16* o, int vb, bf16x8 pa0, bf16x8 pa1, bf16x8 pa2, bf16x8 pa3) {
  pv_one<0>(o[0], vb, pa0, pa1, pa2, pa3); pv_one<1>(o[1], vb, pa0, pa1, pa2, pa3); pv_one<2>(o[2], vb, pa0, pa1, pa2, pa3); pv_one<3>(o[3], vb, pa0, pa1, pa2, pa3);
}

struct ModNone { __device__ __forceinline__ void operator()(f32x16&, f32x16&, int) const {}
  __device__ __forceinline__ bool active(int) const { return true; } };
struct ModSWA { int qrel, hi, qw  ;
  __device__ __forceinline__ bool active(int t) const { return 64 * t <= qw + 159 && 64 * t + 191 >= qw; }
  __device__ __forceinline__ void operator()(f32x16& p0, f32x16& p1, int t) const {
    const int x = qrel - t * 64 - 4 * hi, lo = x - 128, up = x + 128; const float ninf = -__builtin_inff();
#pragma unroll
    for (int r = 0; r < 16; ++r) { const int kc = (r & 3) + 8 * (r >> 2);
      p0[r] = (lo <= kc && up >= kc) ? p0[r] : ninf; p1[r] = (lo <= kc + 32 && up >= kc + 32) ? p1[r] : ninf; }
  } };
struct ModNA { int kr0, qi, qj, rs, cs, hi; const __attribute__((address_space(3))) float* tab;
  __device__ __forceinline__ bool active(int t) const { const int kr = kr0 + t; return kr >= rs && kr < rs + 8; }
  __device__ __forceinline__ void operator()(f32x16& p0, f32x16& p1, int t) const {
    const int kr = kr0 + t; const float ninf = -__builtin_inff();
    if (kr < rs || kr >= rs + 8) {
#pragma unroll
      for (int r = 0; r < 16; ++r) { p0[r] = ninf; p1[r] = ninf; }
    } else {
      const __attribute__((address_space(3))) float* trow = tab + ((kr - qi + 7) * 31 + 15 - qj + 4 * hi);
      const int c0 = 4 * hi - cs;
#pragma unroll
      for (int r = 0; r < 16; ++r) { const int kc = (r & 3) + 8 * (r >> 2); const int ia = kc + c0, ib = ia + 32;
        const float ba = trow[kc], bb = trow[kc + 32];
        p0[r] = ((unsigned)ia < 16u) ? p0[r] + ba : ninf; p1[r] = ((unsigned)ib < 16u) ? p1[r] + bb : ninf; }
    }
  } };

template <int LDQ, int LDK, int LDO, class Mod>
__device__ __forceinline__ void attn_body(const u16* __restrict__ Qb, const u16* __restrict__ Kh, const u16* __restrict__ Vh,
                                          u16* __restrict__ Ob, int NT, char* lds, int wv, const Mod& mod, float m_init, float l_init) {
  const int tid = opaque_tid(wv), wid = tid >> 6, lane = tid & 63, r32 = lane & 31, hi = lane >> 5;
  char* V_lds = lds; char* K_lds = lds + 2 * SHM_V;
  float* ws = (float*)(lds + 2 * SHM_V + 2 * SHM_K) + wid * 64; float* li_l = ws; float* al_l = ws + 32;
  float m_reg = m_init, l_reg = l_init; f32x16 o[4] = {}; bf16x8 qr[8];
  const u16* Qw = Qb + (long)(wid * QBLK + r32) * LDQ + hi * 8;
#pragma unroll
  for (int d0 = 0; d0 < 8; ++d0) qr[d0] = ld8(Qw + d0 * 16);
  const int sr = tid >> 4, sc = (tid & 15) * 8, vst0 = v_st(sr, sc), vst1 = v_st(32 + sr, sc);
  const int vb0 = (int)(uintptr_t)V_lds + v_rd_base(lane);
  struct { bf16x8 vs0, vs1, ks0, ks1; } sr_[1];
#define SLOAD(i, k0) do { sr_[i].vs0 = ld8(&Vh[(long)((k0) + sr) * LDK + sc]); sr_[i].vs1 = ld8(&Vh[(long)((k0) + 32 + sr) * LDK + sc]); \
    sr_[i].ks0 = ld8(&Kh[(long)((k0) + sr) * LDK + sc]); sr_[i].ks1 = ld8(&Kh[(long)((k0) + 32 + sr) * LDK + sc]); } while (0)
#define SWRITE(b, i) do { *(bf16x8*)(V_lds + (b) * SHM_V + vst0) = sr_[i].vs0;          \
    *(bf16x8*)(V_lds + (b) * SHM_V + vst1) = sr_[i].vs1; int kc = sc * 2;               \
    *(bf16x8*)(K_lds + (b) * SHM_K + KSWZ(sr, kc)) = sr_[i].ks0;                       \
    *(bf16x8*)(K_lds + (b) * SHM_K + KSWZ(32 + sr, kc)) = sr_[i].ks1; } while (0)
#define SWAIT() asm volatile("s_waitcnt vmcnt(0)" ::: "memory")
#define RESC(a) do { if (__any((a) < 1.f)) { if (hi == 0) al_l[r32] = (a); asm volatile("s_waitcnt lgkmcnt(0)" ::: "memory"); \
    for (int d = 0; d < 4; ++d) for (int r = 0; r < 16; ++r) o[d][r] *= al_l[crow(r, hi)]; } } while (0)
  f32x16 pA0, pA1, pB0, pB1; float mnA, mnB, alA, alB; bf16x8 pa0, pa1, pa2, pa3;
  constexpr int SE = 0, SO = 0;
  SLOAD(SE, 0); asm volatile("s_waitcnt vmcnt(0)" ::: "memory"); SWRITE(0, SE); __syncthreads();
  if (mod.active(0)) qkt(pA0, pA1, K_lds, qr, r32, hi); else { pA0 = f32x16{}; pA1 = f32x16{}; }
  mod(pA0, pA1, 0); partialSM(pA0, pA1, m_reg, mnA, alA);
  SLOAD(SO, KVBLK);
  SWAIT(); SWRITE(1, SO); __syncthreads();
  for (int j = 1; j + 1 < NT; j += 2) {
    SBAR(); if (mod.active(j)) qkt(pB0, pB1, K_lds + SHM_K, qr, r32, hi); else { pB0 = f32x16{}; pB1 = f32x16{}; }
    finishSM(pA0, pA1, alA, l_reg, pa0, pa1, pa2, pa3); SBAR();
    SLOAD(SO, (j + 1) * KVBLK); SBAR();
    if (mod.active(j - 1)) pv_d0(o, vb0, pa0, pa1, pa2, pa3); mod(pB0, pB1, j); partialSM(pB0, pB1, m_reg, mnB, alB);
    __syncthreads(); SWAIT(); SWRITE(0, SE);
    RESC(alB); __syncthreads();
    SBAR(); if (mod.active(j + 1)) qkt(pA0, pA1, K_lds, qr, r32, hi); else { pA0 = f32x16{}; pA1 = f32x16{}; }
    finishSM(pB0, pB1, alB, l_reg, pa0, pa1, pa2, pa3); SBAR();
    SLOAD(SE, (j + 2) * KVBLK); SBAR();
    if (mod.active(j)) pv_d0(o, vb0 + (int)SHM_V, pa0, pa1, pa2, pa3); mod(pA0, pA1, j + 1); partialSM(pA0, pA1, m_reg, mnA, alA);
    __syncthreads(); SWAIT(); SWRITE(1, SO);
    RESC(alA); __syncthreads();
  }
  SBAR(); if (mod.active(NT - 1)) qkt(pB0, pB1, K_lds + SHM_K, qr, r32, hi); else { pB0 = f32x16{}; pB1 = f32x16{}; }
  finishSM(pA0, pA1, alA, l_reg, pa0, pa1, pa2, pa3); SBAR();
  if (mod.active(NT - 2)) pv_d0(o, vb0, pa0, pa1, pa2, pa3); mod(pB0, pB1, NT - 1); partialSM(pB0, pB1, m_reg, mnB, alB);
  __syncthreads(); RESC(alB);
  finishSM(pB0, pB1, alB, l_reg, pa0, pa1, pa2, pa3); SBAR();
  if (mod.active(NT - 1)) pv_d0(o, vb0 + (int)SHM_V, pa0, pa1, pa2, pa3);
  if (hi == 0) li_l[r32] = l_reg; asm volatile("s_waitcnt lgkmcnt(0)" ::: "memory");
  float rli[16];
#pragma unroll
  for (int r = 0; r < 16; ++r) rli[r] = __builtin_amdgcn_rcpf(li_l[crow(r, hi)]);
  u16* Ow = Ob + (long)(wid * QBLK) * LDO;
#pragma unroll
  for (int r = 0; r < 16; ++r) { int orow = crow(r, hi);
#pragma unroll
    for (int d0 = 0; d0 < 4; ++d0) Ow[(long)orow * LDO + d0 * 32 + r32] = (u16)cvtpk(o[d0][r] * rli[r], 0.f); }
  __syncthreads();
#undef SLOAD
#undef SWRITE
#undef SWAIT
#undef RESC
}
#define PVR(HB, S) const s16x4 S##l0 = tr_read<v_rd_off((HB) >> 1, 2 * ((HB) & 1), 0)>(vb), S##h0 = tr_read<v_rd_off((HB) >> 1, 2 * ((HB) & 1), 1)>(vb), \
    S##l1 = tr_read<v_rd_off((HB) >> 1, 2 * ((HB) & 1) + 1, 0)>(vb), S##h1 = tr_read<v_rd_off((HB) >> 1, 2 * ((HB) & 1) + 1, 1)>(vb)
#define PVK(L, H) (bf16x8){L[0], L[1], L[2], L[3], H[0], H[1], H[2], H[3]}
#define PVM(HB, S, PA, PB) do { o[(HB) >> 1] = __builtin_amdgcn_mfma_f32_32x32x16_bf16(PA, PVK(S##l0, S##h0), o[(HB) >> 1], 0, 0, 0); \
    o[(HB) >> 1] = __builtin_amdgcn_mfma_f32_32x32x16_bf16(PB, PVK(S##l1, S##h1), o[(HB) >> 1], 0, 0, 0); } while (0)
#define PVW(N) do { asm volatile("s_waitcnt lgkmcnt(" #N ")" ::: "memory"); SBAR(); } while (0)
__device__ __forceinline__ void pv_pipe(f32x16* o, int vb, bf16x8 pa0, bf16x8 pa1, bf16x8 pa2, bf16x8 pa3) {
  PVR(0, a); PVR(1, b); PVR(2, c);
  PVW(8); PVM(0, a, pa0, pa1); PVR(3, d);
  PVW(8); PVM(1, b, pa2, pa3); PVR(4, e);
  PVW(8); PVM(2, c, pa0, pa1); PVR(5, f);
  PVW(8); PVM(3, d, pa2, pa3); PVR(6, g);
  PVW(8); PVM(4, e, pa0, pa1); PVR(7, h);
  PVW(8); PVM(5, f, pa2, pa3);
  PVW(4); PVM(6, g, pa0, pa1);
  PVW(0); PVM(7, h, pa2, pa3);
}
#undef PVR
#undef PVK
#undef PVM
#undef PVW
__device__ __forceinline__ void qkt_half(f32x16& p, const char* Ks, const bf16x8* qr, int krow, int hi) {
  p = f32x16{};
  for (int d0 = 0; d0 < 8; ++d0) { int cb = (d0 * 16 + hi * 8) * 2;
    bf16x8 b = *reinterpret_cast<const bf16x8*>(Ks + KSWZ(krow, cb));
    p = __builtin_amdgcn_mfma_f32_32x32x16_bf16(b, qr[d0], p, 0, 0, 0); }
}
__device__ __forceinline__ float halfmax(const f32x16& p) {
  float pmax = p[0]; for (int r = 1; r < 16; ++r) pmax = fmaxf(pmax, p[r]);
  auto rr = __builtin_amdgcn_permlane32_swap(__float_as_uint(pmax), __float_as_uint(pmax), false, false);
  return fmaxf(__uint_as_float(rr[0]), __uint_as_float(rr[1]));
}
template <int LDQ, int LDK, int LDV, int LDO>
__device__ __forceinline__ void attn_dv256_body(const u16* __restrict__ Qb, const u16* __restrict__ Kh, const u16* __restrict__ Vh, u16* __restrict__ Ob, int NT, char* lds, int wv) {
  const int tid = opaque_tid(wv), wid = __builtin_amdgcn_readfirstlane(tid >> 6), lane = tid & 63, r32 = lane & 31, hi = lane >> 5;
  const int rg = wid >> 1, ch = wid & 1;
  char* K_lds = lds;
  char* V_lds = lds + 32768;
  char* PX = lds + 98304;
  float* MX = (float*)(lds + 135168);
  float* al_l = (float*)(lds + 139264) + wid * 64;
  float* LX = (float*)(lds + 141312);
  float m_reg = -1e30f, l_reg = 0.f; f32x16 o[4] = {}; bf16x8 qr[8];
  const u16* Qw = Qb + (long)(rg * 32 + r32) * LDQ + hi * 8;
#pragma unroll
  for (int d0 = 0; d0 < 8; ++d0) qr[d0] = ld8(Qw + d0 * 16);
  const int sr = tid >> 4, sc = (tid & 15) * 8, vst0 = v_st(sr, sc), vst1 = v_st(32 + sr, sc), kcb = sc * 2;
  const int vb0 = (int)(uintptr_t)V_lds + ch * 16384 + v_rd_base(lane);
  const int pxw = (wid * 2 * 64 + lane) * 16, px0 = ((wid & ~1) * 2 * 64 + lane) * 16;
  const int krow = 32 * ch + r32;
  bf16x8 ks0, ks1, vs0, vs1, vs2, vs3;
#define KLOAD(k0) do { ks0 = ld8(&Kh[(long)((k0) + sr) * LDK + sc]); ks1 = ld8(&Kh[(long)((k0) + 32 + sr) * LDK + sc]); } while (0)
#define VLOAD(k0) do { vs0 = ld8(&Vh[(long)((k0) + sr) * LDV + sc]); vs1 = ld8(&Vh[(long)((k0) + 32 + sr) * LDV + sc]); \
    vs2 = ld8(&Vh[(long)((k0) + sr) * LDV + 128 + sc]); vs3 = ld8(&Vh[(long)((k0) + 32 + sr) * LDV + 128 + sc]); } while (0)
#define KWRITE(b) do { *(bf16x8*)(K_lds + (b) * 16384 + KSWZ(sr, kcb)) = ks0; *(bf16x8*)(K_lds + (b) * 16384 + KSWZ(32 + sr, kcb)) = ks1; } while (0)
#define VWRITE(b) do { *(bf16x8*)(V_lds + (b) * 32768 + vst0) = vs0; *(bf16x8*)(V_lds + (b) * 32768 + vst1) = vs1; \
    *(bf16x8*)(V_lds + (b) * 32768 + 16384 + vst0) = vs2; *(bf16x8*)(V_lds + (b) * 32768 + 16384 + vst1) = vs3; } while (0)
#define RESC(a) do { if (__any((a) < 1.f)) { if (hi == 0) al_l[r32] = (a); asm volatile("s_waitcnt lgkmcnt(0)" ::: "memory"); \
    for (int d = 0; d < 4; ++d) for (int r = 0; r < 16; ++r) o[d][r] *= al_l[crow(r, hi)]; } } while (0)
#define PK4(P, BASE, OUT) do { unsigned a0 = cvtpk(P[BASE + 0], P[BASE + 1]), a1 = cvtpk(P[BASE + 2], P[BASE + 3]);   \
    unsigned b0 = cvtpk(P[BASE + 4], P[BASE + 5]), b1 = cvtpk(P[BASE + 6], P[BASE + 7]);                              \
    auto r0 = __builtin_amdgcn_permlane32_swap(a0, b0, false, false); auto r1 = __builtin_amdgcn_permlane32_swap(a1, b1, false, false); \
    u32x4 w = {r0[0], r1[0], r0[1], r1[1]}; OUT = *reinterpret_cast<bf16x8*>(&w); } while (0)
  KLOAD(0); asm volatile("s_waitcnt vmcnt(0)" ::: "memory"); KWRITE(0);
  KLOAD(64); asm volatile("s_waitcnt vmcnt(0)" ::: "memory"); KWRITE(1);
  if (2 < NT) KLOAD(128);
  VLOAD(0);
  __syncthreads();
  f32x16 pC, pN; float pmC, pmN = 0.f;
  qkt_half(pC, K_lds, qr, krow, hi);
  pmC = halfmax(pC); MX[(0 * 8 + wid) * 64 + lane] = pmC;
  __syncthreads();
  for (int t = 0; t < NT; ++t) {
    const int par = t & 1;
    if (t + 1 < NT) qkt_half(pN, K_lds + (par ^ 1) * 16384, qr, krow, hi);
    if (t >= 1) {
      const bf16x8 pa0 = *(const bf16x8*)(PX + (par ^ 1) * 16384 + px0), pa1 = *(const bf16x8*)(PX + (par ^ 1) * 16384 + px0 + 1024);
      const bf16x8 pa2 = *(const bf16x8*)(PX + (par ^ 1) * 16384 + px0 + 2048), pa3 = *(const bf16x8*)(PX + (par ^ 1) * 16384 + px0 + 3072);
      pv_pipe(o, vb0 + (par ^ 1) * 32768, pa0, pa1, pa2, pa3);
    }
    float alpha;
    {
      constexpr float C = SCALE * 1.4426950408889634f;
      const float pmP = MX[(par * 8 + (wid ^ 1)) * 64 + lane];
      const float pmax = fmaxf(pmC, pmP);
      float mn;
      if (__builtin_expect(__all(pmax - m_reg <= THR / SCALE), 1)) { mn = m_reg; alpha = 1.f; }
      else { mn = fmaxf(m_reg, pmax); alpha = __builtin_amdgcn_exp2f((m_reg - mn) * C); m_reg = mn; }
      const float mnC = -mn * C;
      for (int r = 0; r < 16; ++r) pC[r] = __builtin_amdgcn_exp2f(fmaf(pC[r], C, mnC));
      float ps = 0; for (int r = 0; r < 16; ++r) ps += pC[r];
      { auto rr = __builtin_amdgcn_permlane32_swap(__float_as_uint(ps), __float_as_uint(ps), false, false);
        ps = __uint_as_float(rr[0]) + __uint_as_float(rr[1]); }
      l_reg = l_reg * alpha + ps;
      bf16x8 fo0, fo1; PK4(pC, 0, fo0); PK4(pC, 8, fo1);
      *(bf16x8*)(PX + par * 16384 + pxw) = fo0; *(bf16x8*)(PX + par * 16384 + pxw + 1024) = fo1;
    }
    RESC(alpha);
    if (t + 1 < NT) { pmN = halfmax(pN); MX[((par ^ 1) * 8 + wid) * 64 + lane] = pmN; }
    asm volatile("s_waitcnt vmcnt(0)" ::: "memory");
    if (t + 2 < NT) KWRITE(par);
    VWRITE(par);
    if (t + 3 < NT) KLOAD((t + 3) * 64);
    if (t + 1 < NT) VLOAD((t + 1) * 64);
    __syncthreads();
    pC = pN; pmC = pmN;
  }
  {
    const int par = (NT - 1) & 1;
    const bf16x8 pa0 = *(const bf16x8*)(PX + par * 16384 + px0), pa1 = *(const bf16x8*)(PX + par * 16384 + px0 + 1024);
    const bf16x8 pa2 = *(const bf16x8*)(PX + par * 16384 + px0 + 2048), pa3 = *(const bf16x8*)(PX + par * 16384 + px0 + 3072);
    pv_pipe(o, vb0 + par * 32768, pa0, pa1, pa2, pa3);
  }
  LX[wid * 64 + lane] = l_reg;
  __syncthreads();
  const float ltot = l_reg + LX[(wid ^ 1) * 64 + lane];
  if (hi == 0) al_l[r32] = ltot; asm volatile("s_waitcnt lgkmcnt(0)" ::: "memory");
  float rli[16];
#pragma unroll
  for (int r = 0; r < 16; ++r) rli[r] = __builtin_amdgcn_rcpf(al_l[crow(r, hi)]);
  u16* Ow = Ob + (long)(rg * 32) * LDO + ch * 128;
#pragma unroll
  for (int r = 0; r < 16; ++r) { int orow = crow(r, hi);
#pragma unroll
    for (int d0 = 0; d0 < 4; ++d0) Ow[(long)orow * LDO + d0 * 32 + r32] = (u16)cvtpk(o[d0][r] * rli[r], 0.f); }
  __syncthreads();
#undef KLOAD
#undef VLOAD
#undef KWRITE
#undef VWRITE
#undef RESC
#undef PK4
}
}

#ifndef PROBE
#define PROBE 0
#endif
#ifndef EN_NA
#define EN_NA 1
#endif
#ifndef EN_SWA
#define EN_SWA 1
#endif
#ifndef EN_DIFF
#define EN_DIFF 1
#endif
#ifndef EN_MEM
#define EN_MEM 1
#endif
#ifndef EN_EPI
#define EN_EPI -1
#endif
#ifndef EN_GEMM
#define EN_GEMM 1
#endif
#define LAS __attribute__((address_space(3)))
typedef unsigned short bf16;
typedef unsigned v4u __attribute__((ext_vector_type(4)));
typedef unsigned v2u __attribute__((ext_vector_type(2)));
typedef float f32x4 __attribute__((ext_vector_type(4)));
constexpr int NWAVES = 8, NTHREADS = 512;
constexpr int S_ = 8192, DM = 2048, MEMLEN = 256, DFF = 8192;
constexpr int EVEN_IN = 4608, ODD_IN = 6144, MEMW = 512;
constexpr float EPS = 1e-6f;
constexpr float LAMBDA_INIT1 = 0.35550906f;
constexpr int LDS_BYTES = 147456;
constexpr int NA_TAB_OFF = 67584 + 512;
constexpr size_t MiB = 1u << 20;
constexpr size_t WS_WIN0 = 0, WS_WOUT0 = 18 * MiB, WS_WIN1 = 26 * MiB, WS_WOUT1 = 50 * MiB, WS_WQ = 58 * MiB  , WS_WKV = 62 * MiB  ,
                 WS_WO = 70 * MiB  , WS_WUP = 74 * MiB  , WS_WDN = 138 * MiB  , WS_MEMN = 202 * MiB, WS_KVM = 204 * MiB,
                 WS_ROPE = 205 * MiB, WS_HN = 206 * MiB, WS_YC = 238 * MiB, WS_Y = 270 * MiB, WS_R1 = 334 * MiB, WS_CTL = 498 * MiB, WS_END = 499 * MiB;
constexpr size_t CTL_ZERO_BYTES = 16384;
constexpr int MISC_OFF = 131072 + 320;
constexpr size_t WS_PROJ = WS_R1, WS_OD = WS_R1 + 96 * MiB, WS_U = WS_R1, WS_QM = WS_R1, WS_OM = WS_R1 + 8 * MiB;

struct Params { const float* in[26]; float* out; unsigned char* ws; };
typedef const __attribute__((address_space(4))) Params* KPtr;
__device__ __forceinline__ KPtr kp() { KPtr p = (KPtr)__builtin_amdgcn_kernarg_segment_ptr(); asm volatile("" : "+s"(p)); return p; }

__device__ __forceinline__ unsigned f2bf(float f) { unsigned u = __builtin_bit_cast(unsigned, f); return (u + 0x7fffu + ((u >> 16) & 1u)) >> 16; }
__device__ __forceinline__ unsigned pk2(float lo, float hi) { return f2bf(lo) | (f2bf(hi) << 16); }
__device__ __forceinline__ float bf_lo(unsigned w) { return __builtin_bit_cast(float, w << 16); }
__device__ __forceinline__ float bf_hi(unsigned w) { return __builtin_bit_cast(float, w & 0xffff0000u); }
__device__ __forceinline__ float wave_sum(float v) {
#pragma unroll
    for (int o = 1; o < 64; o <<= 1) v += __shfl_xor(v, o);
    return v;
}
#define LDS_WAIT() asm volatile("s_waitcnt lgkmcnt(0)" ::: "memory")

__device__ __forceinline__ void transpose_item(const float* __restrict__ W, int K, int N, bf16* __restrict__ WT, int ldk, int row_off, LAS float* scr, int item, int lane) {
    const int nblk = N / 32, kb = item / nblk, nb = item % nblk, k0 = 64 * kb, n0 = 32 * nb;
    float tv[32];
#pragma unroll
    for (int i = 0; i < 32; ++i) { const int kk = 2 * i + (lane >> 5); tv[i] = __builtin_nontemporal_load(&W[(size_t)(k0 + kk) * N + n0 + (lane & 31)]); }
#pragma unroll
    for (int i = 0; i < 32; ++i) { const int kk = 2 * i + (lane >> 5); scr[kk * 33 + (lane & 31)] = tv[i]; }
    LDS_WAIT(); asm volatile("" ::: "memory");
    const int c = lane & 7;
#pragma unroll
    for (int j = 0; j < 4; ++j) { const int n = (lane >> 3) + 8 * j; const LAS float* s = scr + (8 * c) * 33 + n;
        v4u o; o.x = pk2(s[0 * 33], s[1 * 33]); o.y = pk2(s[2 * 33], s[3 * 33]); o.z = pk2(s[4 * 33], s[5 * 33]); o.w = pk2(s[6 * 33], s[7 * 33]);
        *(v4u*)(WT + (size_t)(row_off + n0 + n) * ldk + k0 + 8 * c) = o; }
    LDS_WAIT(); asm volatile("" ::: "memory");
}
__device__ __forceinline__ void transpose_matrix(const float* W, int K, int N, bf16* WT, int row_off, LAS float* scr, int gw, int NGW, int lane, int& base, int ldk = 0) {
    if (ldk == 0) ldk = K;
    const int items = (K / 64) * (N / 32);
    int first = (gw - base) % NGW; if (first < 0) first += NGW;
    for (int it = first; it < items; it += NGW) transpose_item(W, K, N, WT, ldk, row_off, scr, it, lane);
    base = (base + items) % NGW;
}

__device__ __forceinline__ void rms_row_bf16(const float* __restrict__ xrow, const float* __restrict__ g, bf16* __restrict__ orow, int lane) {
    const f32x4* xr = (const f32x4*)xrow + lane; const f32x4* gr = (const f32x4*)g + lane;
    f32x4 v[8]; float s = 0.f;
#pragma unroll
    for (int j = 0; j < 8; ++j) { v[j] = xr[64 * j]; s += (v[j].x * v[j].x + v[j].y * v[j].y) + (v[j].z * v[j].z + v[j].w * v[j].w); }
    const float rinv = 1.f / sqrtf(wave_sum(s) * (1.f / DM) + EPS);
    v2u* o8 = (v2u*)orow + lane;
#pragma unroll
    for (int j = 0; j < 8; ++j) { const f32x4 gg = gr[64 * j]; v2u w; w.x = pk2(v[j].x * rinv * gg.x, v[j].y * rinv * gg.y); w.y = pk2(v[j].z * rinv * gg.z, v[j].w * rinv * gg.w); o8[64 * j] = w; }
}
template <bool HIN_F32, bool HOUT_F32>
__device__ __forceinline__ void resid_row(const void* __restrict__ hin, const bf16* __restrict__ y  , const float* __restrict__ gpost, const float* __restrict__ gpre,
                                          void* __restrict__ hout, bf16* __restrict__ hn, int lane) {
    const v2u* yr = (const v2u*)y + lane; const f32x4* gp = (const f32x4*)gpost + lane;
    f32x4 v[8], hh[8]; float s = 0.f;
#pragma unroll
    for (int j = 0; j < 8; ++j) { const v2u w = yr[64 * j]; v[j] = (f32x4){bf_lo(w.x), bf_hi(w.x), bf_lo(w.y), bf_hi(w.y)}; }
    if constexpr (HIN_F32) { const f32x4* hr = (const f32x4*)hin + lane;
#pragma unroll
        for (int j = 0; j < 8; ++j) hh[j] = hr[64 * j];
    } else { const v2u* hr = (const v2u*)hin + lane;
#pragma unroll
        for (int j = 0; j < 8; ++j) { const v2u w = hr[64 * j]; hh[j] = (f32x4){bf_lo(w.x), bf_hi(w.x), bf_lo(w.y), bf_hi(w.y)}; }
    }
#pragma unroll
    for (int j = 0; j < 8; ++j) s += (v[j].x * v[j].x + v[j].y * v[j].y) + (v[j].z * v[j].z + v[j].w * v[j].w);
    const float rinv = 1.f / sqrtf(wave_sum(s) * (1.f / DM) + EPS);
    float s2 = 0.f;
#pragma unroll
    for (int j = 0; j < 8; ++j) { const f32x4 gg = gp[64 * j];
        v[j] = hh[j] + (v[j] * rinv) * gg;
        if constexpr (HOUT_F32) ((f32x4*)hout + lane)[64 * j] = v[j];
        else { v2u w; w.x = pk2(v[j].x, v[j].y); w.y = pk2(v[j].z, v[j].w); ((v2u*)hout + lane)[64 * j] = w; }
        s2 += (v[j].x * v[j].x + v[j].y * v[j].y) + (v[j].z * v[j].z + v[j].w * v[j].w); }
    if (gpre) {
        const float rinv2 = 1.f / sqrtf(wave_sum(s2) * (1.f / DM) + EPS);
        const f32x4* gq = (const f32x4*)gpre + lane; v2u* o8 = (v2u*)hn + lane;
#pragma unroll
        for (int j = 0; j < 8; ++j) { const f32x4 gg = gq[64 * j]; v2u w; w.x = pk2(v[j].x * rinv2 * gg.x, v[j].y * rinv2 * gg.y); w.y = pk2(v[j].z * rinv2 * gg.z, v[j].w * rinv2 * gg.w); o8[64 * j] = w; }
    }
}

template <class Epi>
__device__ __forceinline__ void run_gemm(PG8_LAS unsigned char* lds, int wv, const bf16* A, const bf16* Bt, int M, int N, int K, const Epi& E, int crot = 0  ) {
    pg8::Gemm g{A, Bt, M, N, K}; pg8::StaticOrder S; S.init(M, N, (int)gridDim.x, (int)((blockIdx.x + gridDim.x - (unsigned)crot) % gridDim.x));
    if (EN_GEMM && (EN_EPI < 0 || EN_EPI == Epi::ID)) pg8::gemm_phase<Epi, pg8::StaticOrder, true, true>(lds, g, S, E, wv);
}
template <bool HIN_F32, bool HOUT_F32>
__device__ __forceinline__ void resid_phase(int wv, const void* hin, const bf16* y, const float* gpost, const float* gpre, void* hout, bf16* hn) {
    const int tid = opaque_tid(wv), lane = tid & 63, gw = blockIdx.x * NWAVES + (tid >> 6), NGW = gridDim.x * NWAVES;
    constexpr size_t SIN = HIN_F32 ? 4 : 2, SOUT = HOUT_F32 ? 4 : 2;
    for (int m = gw; m < S_; m += NGW) resid_row<HIN_F32, HOUT_F32>((const char*)hin + (size_t)m * DM * SIN, y + (size_t)m * DM, gpost, gpre, (char*)hout + (size_t)m * DM * SOUT, hn + (size_t)m * DM, lane);
}
#define XB_TMO      128
#define XB_XCNT(j)  (256  + 64 * (j))
#define XB_XSUB(j)  (1280 + 64 * (j))
#define XB_XGEN(j)  (2304 + 64 * (j))
#define XB_TOP      3328
#define XB_TOPGEN   3392
#define XCD_BAR_WORDS 3456
#define XB_SPIN_CAP (1u << 18)

__device__ __forceinline__ unsigned xb_ld(unsigned* p)              { return __hip_atomic_load(p, __ATOMIC_RELAXED, __HIP_MEMORY_SCOPE_AGENT); }
__device__ __forceinline__ unsigned xb_add(unsigned* p, unsigned v) { return __hip_atomic_fetch_add(p, v, __ATOMIC_RELAXED, __HIP_MEMORY_SCOPE_AGENT); }
__device__ __forceinline__ unsigned xb_xcc_id() { return (unsigned)__builtin_amdgcn_s_getreg((3 << 11) | 20) & 0xFu; }
#define XB_SPIN(cond, bar) do { unsigned _sp = 0; while (cond) { __builtin_amdgcn_s_sleep(1); \
    if ((++_sp & 255u) == 0u) { if (xb_ld(&(bar)[XB_TMO])) break; if (_sp > XB_SPIN_CAP) { atomicAdd(&(bar)[XB_TMO], 1u); break; } } } } while (0)

struct XcdBarrier {
    unsigned* bar; unsigned x;
    volatile LAS unsigned* st;
};

__device__ __forceinline__ XcdBarrier xcd_barrier_post(unsigned* bar, volatile LAS unsigned* st) {
    XcdBarrier b; b.bar = bar; b.x = xb_xcc_id(); b.st = st;
    if (threadIdx.x == 0) (void)xb_add(&bar[XB_XCNT(b.x)], 1u);
    return b;
}
__device__ __forceinline__ void xcd_barrier_complete(unsigned* bar, unsigned x, unsigned& nloc, unsigned& nx) {
    const unsigned G = gridDim.x * gridDim.y * gridDim.z;
    unsigned sum, cnt, mine, sp = 0u;
    for (;;) {
        sum = 0u; cnt = 0u; mine = 0u;
#pragma unroll
        for (unsigned j = 0; j < 16; ++j) { const unsigned c = xb_ld(&bar[XB_XCNT(j)]); sum += c; cnt += (c > 0u) ? 1u : 0u; mine = (j == x) ? c : mine; }
        if (sum == G) break;
        __builtin_amdgcn_s_sleep(1);
        if ((++sp & 255u) == 0u) { if (xb_ld(&bar[XB_TMO])) break; if (sp > XB_SPIN_CAP) { atomicAdd(&bar[XB_TMO], 1u); break; } }
    }
    nloc = mine > 0u ? mine : 1u; nx = cnt > 0u ? cnt : 1u;
}

__device__ __forceinline__ void xcd_barrier(const XcdBarrier& b, bool leader) {
    asm volatile("s_waitcnt vmcnt(0)" ::: "memory");
    __syncthreads();
    if (leader) {
        unsigned* bar = b.bar;
        __builtin_amdgcn_s_waitcnt(0);
        unsigned nloc = b.st[0], nx = b.st[1];
        if (nloc == 0u) { xcd_barrier_complete(bar, b.x, nloc, nx); b.st[0] = nloc; b.st[1] = nx; }
        const unsigned old = xb_add(&bar[XB_XSUB(b.x)], 1u);
        const unsigned gen = old / nloc;
        if (old + 1u == (gen + 1u) * nloc) {
            __builtin_amdgcn_fence(__ATOMIC_RELEASE, "agent");
            asm volatile("s_waitcnt vmcnt(0)" ::: "memory");
            const unsigned og = xb_add(&bar[XB_TOP], 1u);
            const unsigned tg = og / nx;
            if (og + 1u == (tg + 1u) * nx) xb_add(&bar[XB_TOPGEN], 1u);
            else XB_SPIN(xb_ld(&bar[XB_TOPGEN]) == tg, bar);
            __builtin_amdgcn_fence(__ATOMIC_ACQUIRE, "agent");
            xb_add(&bar[XB_XGEN(b.x)], 1u);
            asm volatile("s_waitcnt vmcnt(0)" ::: "memory");
        } else {
            XB_SPIN(xb_ld(&bar[XB_XGEN(b.x)]) == gen, bar);
            __builtin_amdgcn_fence(__ATOMIC_ACQUIRE, "agent");
            asm volatile("s_waitcnt vmcnt(0)" ::: "memory");
        }
    }
    __syncthreads();
}

__global__ void __launch_bounds__(NTHREADS, 2) fwd_megakernel(Params P) {
    extern __shared__ __attribute__((aligned(16))) unsigned char lds[];
    cg::grid_group grid = cg::this_grid();
    const int wave_s = __builtin_amdgcn_readfirstlane((int)threadIdx.x >> 6);
    {
        volatile LAS unsigned* misc0 = (volatile LAS unsigned*)((LAS unsigned char*)lds + MISC_OFF);
        if (threadIdx.x < 16) misc0[threadIdx.x] = 0u;
        __syncthreads();
        (void)xcd_barrier_post((unsigned*)(kp()->ws + WS_CTL), misc0 + 8);
    }
#define SLOT_BEGIN(c0_) { int gqs_ = (int)gridDim.x; asm volatile("" : "+s"(gqs_)); const int c0s_ = (gqs_ == 256) ? (c0_) : 0; if (bx >= c0s_) { PHASE_IDS(); LAS float* scr = (LAS float*)(ldsp + wave * 16384); const int gws = (bx - c0s_) * NWAVES + wave, NGWS = (gqs_ - c0s_) * NWAVES; int base = 0; (void)gw;
#define SLOT_T(W_, K_, N_, WT_, LDK_) transpose_matrix(W_, K_, N_, WT_, 0, scr, gws, NGWS, lane, base, LDK_)
#define SLOT_END() } }
#define GSYNC() do { XcdBarrier b_; b_.bar = (unsigned*)(kp()->ws + WS_CTL); b_.x = xb_xcc_id(); b_.st = (volatile LAS unsigned*)((LAS unsigned char*)lds + MISC_OFF) + 8; xcd_barrier(b_, opaque_tid(wave_s) == 0); } while (0)
    PG8_LAS unsigned char* ldsp = (PG8_LAS unsigned char*)lds;
    const int G = gridDim.x, bx = blockIdx.x, NGW = G * NWAVES;
#define PHASE_IDS() const int tid = opaque_tid(wave_s), lane = tid & 63, wave = __builtin_amdgcn_readfirstlane(tid >> 6), gw = bx * NWAVES + wave; (void)lane; (void)gw
#define WSB (kp()->ws)
#define X_IN (kp()->in[0])
#define MEM_IN (kp()->in[1])
#define Win_t0 ((bf16*)(WSB + WS_WIN0))
#define Win_t1 ((bf16*)(WSB + WS_WIN1))
#define Wout_t0 ((bf16*)(WSB + WS_WOUT0))
#define Wout_t1 ((bf16*)(WSB + WS_WOUT1))
#define MEMN ((bf16*)(WSB + WS_MEMN))
#define KVM ((bf16*)(WSB + WS_KVM))
#define ROPE ((float*)(WSB + WS_ROPE))
#define HN ((bf16*)(WSB + WS_HN))
#define YC ((bf16*)(WSB + WS_YC))
#define Y_BUF ((bf16*)(WSB + WS_Y))
#define PROJ ((bf16*)(WSB + WS_PROJ))
#define OD ((bf16*)(WSB + WS_OD))
#define U_BUF ((bf16*)(WSB + WS_U))
#define QM ((bf16*)(WSB + WS_QM))
#define OM ((bf16*)(WSB + WS_OM))
#define H_BUF (kp()->out)
#define HB_BUF ((bf16*)(WSB + WS_Y + 32 * MiB))
    for (int rep_ = 0; rep_ < (PROBE == 1 ? 2 : 1); ++rep_) {
        PHASE_IDS();
        LAS float* scr = (LAS float*)(ldsp + wave * 16384);
        int base = 0;
        transpose_matrix(kp()->in[2], DM, EVEN_IN, Win_t0, 0, scr, gw, NGW, lane, base);
        for (int l = 0; l < 2; ++l) {
            transpose_matrix(kp()->in[19] + (size_t)l * DM * MEMW, DM, MEMW, (bf16*)(WSB + WS_WKV + l * 4 * MiB), 0, scr, gw, NGW, lane, base);
            transpose_matrix(kp()->in[20] + (size_t)l * DM * MEMW, DM, MEMW, (bf16*)(WSB + WS_WKV + l * 4 * MiB), MEMW, scr, gw, NGW, lane, base);
        }
        for (int i = bx * NTHREADS + tid; i < S_ * 16; i += G * NTHREADS) {
            const int pos = i >> 4, k = i & 15;
            const float inv = (float)exp2(-(double)k * (18.931568569324174 / 16.0));
            const float ang = (float)pos * inv;
            double t = (double)ang * 0.15915494309189535; t -= rint(t);
            const float fr = (float)t;
            ROPE[2 * i] = __builtin_amdgcn_cosf(fr); ROPE[2 * i + 1] = __builtin_amdgcn_sinf(fr);
        }
        for (int m = gw; m < 2 * MEMLEN; m += NGW) { const int l = m / MEMLEN, r = m % MEMLEN;
            rms_row_bf16(MEM_IN + (size_t)r * DM, kp()->in[15] + l * DM, MEMN + (size_t)m * DM, lane); }
        for (int m = gw; m < S_; m += NGW) rms_row_bf16(X_IN + (size_t)m * DM, kp()->in[13], HN + (size_t)m * DM, lane);
    }
    if (gridDim.x == 0x7fffffffu) grid.sync();
    GSYNC();

    for (int layer = 0; layer < 2; ++layer) {

        if (layer == 0) {
            run_gemm(ldsp, wave_s, HN, Win_t0, S_, EVEN_IN, DM, pg8::EpiBf16Rope{PROJ, EVEN_IN, ROPE, 24, 34});
            for (int l = 0; l < 2; ++l)
                run_gemm(ldsp, wave_s, MEMN + (size_t)l * MEMLEN * DM, (const bf16*)(WSB + WS_WKV + l * 4 * MiB), MEMLEN, 2 * MEMW, DM, pg8::EpiBf16<0>{KVM + (size_t)l * MEMLEN * 2 * MEMW, 2 * MEMW}, 64 + 4 * l);
            SLOT_BEGIN(64)
                SLOT_T(kp()->in[3], DM, DM, Wout_t0, 0);
                SLOT_T(kp()->in[18], DM, MEMW, (bf16*)(WSB + WS_WQ), 0);
                SLOT_T(kp()->in[21], MEMW, DM, (bf16*)(WSB + WS_WO), 0);
                SLOT_T(kp()->in[24], DM, DFF, (bf16*)(WSB + WS_WUP), 0);
                SLOT_T(kp()->in[25], DFF, DM, (bf16*)(WSB + WS_WDN), 0);
            SLOT_END()
        } else {
            run_gemm(ldsp, wave_s, HN, Win_t1, S_, ODD_IN, DM, pg8::EpiBf16Rope{PROJ, ODD_IN, ROPE, 0, 32});
        }
        GSYNC();
        if (layer == 0) {
            PHASE_IDS();
            const int r32 = lane & 31, hi = lane >> 5;
            for (int u = bx; u < 512; u += G) {
                const int kind = u >> 8, uu = u & 255, hd = uu & 7, qb = uu >> 3;
                if (kind == 0) {
                    LAS float* tab = (LAS float*)(ldsp + NA_TAB_OFF);
                    __syncthreads();
                    if (tid < 465) tab[tid] = kp()->in[4][hd * 465 + tid] * (1.f / att::SCALE);
                    __syncthreads();
                    const int i0 = 4 * qb, kr0 = min(max(i0 - 4, 0), 120), thi = min(max(i0 - 1, 0), 120) + 7;
                    int NT = thi - kr0 + 1; NT += NT & 1;
                    const int qi = i0 + (wave >> 1), qj = 32 * (wave & 1) + r32;
                    att::ModNA mod{kr0, qi, qj, min(max(qi - 4, 0), 120), min(max(qj - 8, 0), 48), hi, tab};
                    if (EN_NA) att::attn_body<EVEN_IN, EVEN_IN, DM, att::ModNA>(PROJ + (size_t)(256 * qb) * EVEN_IN + hd * 128, PROJ + (size_t)(kr0 * 64) * EVEN_IN + 1024 + hd * 128,
                        PROJ + (size_t)(kr0 * 64) * EVEN_IN + 2048 + hd * 128, YC + (size_t)(256 * qb) * DM + hd * 128, NT, (char*)lds, wave_s, mod, -1e30f, 0.f);
                } else {
                    const int q0 = 256 * qb, ks = max(q0 - 128, 0), ke = min(q0 + 384, S_), NT = (ke - ks) / 64, kvh = hd >> 2;
                    att::ModSWA mod{q0 + wave * 32 + r32 - ks, hi, q0 + wave * 32 - ks};
                    const float sink = kp()->in[5][hd];
                    if (EN_SWA) att::attn_body<EVEN_IN, EVEN_IN, DM, att::ModSWA>(PROJ + (size_t)q0 * EVEN_IN + 3072 + hd * 128, PROJ + (size_t)ks * EVEN_IN + 4096 + kvh * 128,
                        PROJ + (size_t)ks * EVEN_IN + 4352 + kvh * 128, YC + (size_t)q0 * DM + 1024 + hd * 128, NT, (char*)lds, wave_s, mod, sink * (1.f / att::SCALE), 1.f);
                }
            }
        } else {
            for (int rep_ = 0; rep_ < (PROBE == 2 ? 2 : 1); ++rep_)
            for (int u = bx; u < 1024; u += G) {
                const int i = u >> 8, c = u & 255, combo = 2 * (c & 7) + (i >> 1), qb = (i & 1) * 32 + (c >> 3);
                const int h = combo >> 1;
                if (EN_DIFF) att::attn_dv256_body<ODD_IN, ODD_IN, ODD_IN, 4096>(PROJ + (size_t)(128 * qb) * ODD_IN + combo * 128, PROJ + 2048 + combo * 128,
                    PROJ + 4096 + h * 256, OD + (size_t)(128 * qb) * 4096 + combo * 256, S_ / 64, (char*)lds, wave_s);
            }
            if (G == 256) { asm volatile("s_waitcnt vmcnt(0)" ::: "memory"); __syncthreads(); } else GSYNC();
            {
                PHASE_IDS();
                const float a1 = kp()->in[8][lane] * kp()->in[9][lane] + kp()->in[8][lane + 64] * kp()->in[9][lane + 64];
                const float a2 = kp()->in[10][lane] * kp()->in[11][lane] + kp()->in[10][lane + 64] * kp()->in[11][lane + 64];
                const float lam = expf(wave_sum(a1)) - expf(wave_sum(a2)) + LAMBDA_INIT1;
                const f32x4 gg = ((const f32x4*)kp()->in[12])[lane];
                const int nit = (G == 256) ? 256 : S_ * 8;
                for (int it = (G == 256) ? wave : gw; it < nit; it += (G == 256) ? NWAVES : NGW) {
                    const int row = (G == 256) ? 128 * ((it >> 7) * 32 + (bx >> 3)) + (it & 127) : it >> 3, h = (G == 256) ? (bx & 7) : it & 7;
                    const v2u o0 = *((const v2u*)(OD + (size_t)row * 4096 + (h * 2) * 256) + lane), o1 = *((const v2u*)(OD + (size_t)row * 4096 + (h * 2 + 1) * 256) + lane);
                    f32x4 d; d.x = bf_lo(o0.x) - lam * bf_lo(o1.x); d.y = bf_hi(o0.x) - lam * bf_hi(o1.x); d.z = bf_lo(o0.y) - lam * bf_lo(o1.y); d.w = bf_hi(o0.y) - lam * bf_hi(o1.y);
                    const float ss = wave_sum((d.x * d.x + d.y * d.y) + (d.z * d.z + d.w * d.w));
                    const float rinv = (1.f - LAMBDA_INIT1) / sqrtf(ss * (1.f / 256.f) + EPS);
                    v2u w; w.x = pk2(d.x * rinv * gg.x, d.y * rinv * gg.y); w.y = pk2(d.z * rinv * gg.z, d.w * rinv * gg.w);
                    *((v2u*)(YC + (size_t)row * DM + h * 256) + lane) = w;
                }
            }
        }
        GSYNC();
        run_gemm(ldsp, wave_s, YC, (layer == 0 ? Wout_t0 : Wout_t1), S_, DM, DM, pg8::EpiBf16<0>{Y_BUF, DM});
        GSYNC();
        if (layer == 0) resid_phase<true, false>(wave_s, X_IN, Y_BUF, kp()->in[14], kp()->in[16], HB_BUF, HN);
        else resid_phase<false, false>(wave_s, HB_BUF, Y_BUF, kp()->in[14] + DM, kp()->in[16] + DM, HB_BUF, HN);
        GSYNC();
        run_gemm(ldsp, wave_s, HN, (const bf16*)(WSB + WS_WQ + layer * 2 * MiB), S_, MEMW, DM, pg8::EpiBf16<0>{QM, MEMW});
        if (layer == 0) {
            SLOT_BEGIN(64)
                SLOT_T(kp()->in[6], DM, ODD_IN, Win_t1, 0);
                SLOT_T(kp()->in[7], DM, DM, Wout_t1, 0);
                SLOT_T(kp()->in[18] + (size_t)DM * MEMW, DM, MEMW, (bf16*)(WSB + WS_WQ + 2 * MiB), 0);
                SLOT_T(kp()->in[21] + (size_t)MEMW * DM, MEMW, DM, (bf16*)(WSB + WS_WO + 2 * MiB), 0);
                SLOT_T(kp()->in[24] + (size_t)DM * DFF, DM / 2, DFF, (bf16*)(WSB + WS_WUP + 32 * MiB), DM);
            SLOT_END()
        } else {
            SLOT_BEGIN(64)
                SLOT_T(kp()->in[24] + (size_t)DM * DFF + (size_t)(DM / 2) * DFF, DM / 2, DFF, (bf16*)(WSB + WS_WUP + 32 * MiB) + DM / 2, DM);
                SLOT_T(kp()->in[25] + (size_t)DFF * DM, DFF, DM, (bf16*)(WSB + WS_WDN + 32 * MiB), 0);
            SLOT_END()
        }
        GSYNC();
        for (int u = bx; u < 128; u += G) {
            const int hd = u & 3, qb = u >> 2; const bf16* kv = KVM + (size_t)layer * MEMLEN * 2 * MEMW;
            if (EN_MEM) att::attn_body<MEMW, 2 * MEMW, MEMW, att::ModNone>(QM + (size_t)(256 * qb) * MEMW + hd * 128, kv + hd * 128, kv + MEMW + hd * 128,
                OM + (size_t)(256 * qb) * MEMW + hd * 128, MEMLEN / 64, (char*)lds, wave_s, att::ModNone{}, -1e30f, 0.f);
        }
        GSYNC();
        run_gemm(ldsp, wave_s, OM, (const bf16*)(WSB + WS_WO + layer * 2 * MiB), S_, DM, MEMW, pg8::EpiBf16<0>{Y_BUF, DM});
        GSYNC();
        resid_phase<false, false>(wave_s, HB_BUF, Y_BUF, kp()->in[17] + layer * DM, kp()->in[22] + layer * DM, HB_BUF, HN);
        GSYNC();
        for (int rep_ = 0; rep_ < ((PROBE == 3 && layer == 0) ? 2 : 1); ++rep_) {
        run_gemm(ldsp, wave_s, HN, (const bf16*)(WSB + WS_WUP + layer * 32 * MiB), S_, DFF, DM, pg8::EpiBf16<1>{U_BUF, DFF});
        GSYNC();
        run_gemm(ldsp, wave_s, U_BUF, (const bf16*)(WSB + WS_WDN + layer * 32 * MiB), S_, DM, DFF, pg8::EpiBf16<0>{Y_BUF, DM});
        GSYNC();
        }
        if (layer == 0) resid_phase<false, false>(wave_s, HB_BUF, Y_BUF, kp()->in[23], kp()->in[13] + DM, HB_BUF, HN);
        else resid_phase<false, true>(wave_s, HB_BUF, Y_BUF, kp()->in[23] + DM, nullptr, H_BUF, HN);
        if (layer == 0) GSYNC();
    }
}

extern "C" void kernel_launch(void* const* d_in, const int* in_sizes, int n_in, void* d_out, int out_size, void* d_ws, size_t ws_size, hipStream_t stream) {
    static int grid = 0;
    if (grid == 0) {
        if (n_in != 26 || out_size != S_ * DM || ws_size < WS_END) { fprintf(stderr, "kernel_launch: unexpected shapes: n_in %d out %d ws %zu (need %zu)\n", n_in, out_size, ws_size, (size_t)WS_END); grid = -1; return; }
        int dev = 0, cus = 0, per_cu = 0;
        hipGetDevice(&dev); hipDeviceGetAttribute(&cus, hipDeviceAttributeMultiprocessorCount, dev);
        if (hipFuncSetAttribute((const void*)fwd_megakernel, hipFuncAttributeMaxDynamicSharedMemorySize, LDS_BYTES) != hipSuccess) { fprintf(stderr, "kernel_launch: hipFuncSetAttribute failed\n"); grid = -1; return; }
        if (hipOccupancyMaxActiveBlocksPerMultiprocessor(&per_cu, (const void*)fwd_megakernel, NTHREADS, LDS_BYTES) != hipSuccess || per_cu < 1) { fprintf(stderr, "kernel_launch: occupancy query says %d\n", per_cu); per_cu = 1; }
        (void)hipGetLastError();
        grid = cus;
        if (grid != 256) fprintf(stderr, "kernel_launch: %d CUs (expected 256)\n", grid);
    }
    if (grid < 0) return;
    if (hipMemsetAsync((char*)d_ws + WS_CTL, 0, CTL_ZERO_BYTES, stream) != hipSuccess) { fprintf(stderr, "kernel_launch: memset failed\n"); return; }
    Params p{};
    for (int i = 0; i < 26; ++i) p.in[i] = (const float*)d_in[i];
    p.out = (float*)d_out; p.ws = (unsigned char*)d_ws;
    void* args[] = {&p};
    hipError_t e = hipLaunchCooperativeKernel((const void*)fwd_megakernel, dim3(grid), dim3(NTHREADS), args, LDS_BYTES, stream);
    if (e != hipSuccess) fprintf(stderr, "kernel_launch: cooperative launch failed: %s (grid %d)\n", hipGetErrorString(e), grid);
}
```

```cpp
#include <hip/hip_runtime.h>
#include <hip/hip_cooperative_groups.h>
#include <cstdio>
#include <cstdint>
namespace cg = cooperative_groups;
__device__ __forceinline__ int opaque_tid(int wv) { int t; asm volatile("v_mbcnt_lo_u32_b32 %0, -1, 0\n\tv_mbcnt_hi_u32_b32 %0, -1, %0\n\tv_lshl_add_u32 %0, %1, 6, %0" : "=&v"(t) : "s"(wv)); return t; }

namespace pg8 {
#define PG8_LAS __attribute__((address_space(3)))
typedef unsigned short bf16_t;
typedef short bf16x8 __attribute__((ext_vector_type(8)));
typedef float f32x4 __attribute__((ext_vector_type(4)));
typedef unsigned u32x4 __attribute__((ext_vector_type(4)));
constexpr int BM = 256, BK = 64, HALF = 128, HTB = HALF * BK * 2  , STAGE_BYTES = 8 * HTB, NXCD = 8, WGM = 4;

__host__ __device__ __forceinline__ int lds_byte(int r, int c) { const int st = (r >> 4) * 2 + (c >> 5), rr = r & 15, cc = c & 31, ob = rr * 64 + cc * 2; return st * 1024 + (ob ^ (((ob >> 9) & 1) << 5)); }
__host__ __device__ __forceinline__ void stage_rc(int b, int& R, int& C) { const int st = b / 1024, sb = b % 1024, swz = sb ^ (((sb >> 9) & 1) << 5); R = (st >> 1) * 16 + swz / 64; C = (st & 1) * 32 + (swz % 64) / 2; }
__host__ __device__ __forceinline__ int perm32(int rho) { const int n = rho >> 4, i = rho & 15; return 8 * (i >> 2) + 4 * n + (i & 3); }

struct Unit { int pm, pn; };
struct Gemm { const bf16_t* A; const bf16_t* Bt; int M, N, K; };

struct StaticOrder {
    int nM, nN, nwg, G, c;
    __host__ __device__ void init(int M, int N, int G_, int c_) { nM = M / BM; nN = N / BM; nwg = nM * nN; G = G_; c = c_; }
    __host__ __device__ bool next(int i, Unit& u) const {
        const long L = (long)i * G + c; if (L >= nwg) return false;
        int wgid = (int)L; { const int q = nwg / NXCD, r = nwg % NXCD, xcd = wgid % NXCD, off = wgid / NXCD; wgid = (xcd < r ? xcd * (q + 1) : r * (q + 1) + (xcd - r) * q) + off; }
        const int nig = WGM * nN, gid = wgid / nig, fm = gid * WGM, gsz = (nM - fm) < WGM ? (nM - fm) : WGM;
        u.pm = fm + ((wgid % nig) % gsz); u.pn = (wgid % nig) / gsz; return true;
    }
    __device__ __forceinline__ void a_ready(const Unit&) const {}
    __device__ __forceinline__ void done(const Unit&) const {}
};

__device__ __forceinline__ unsigned cvt_pk_bf16(float lo, float hi) { unsigned r; asm volatile("v_cvt_pk_bf16_f32 %0, %1, %2" : "=v"(r) : "v"(lo), "v"(hi)); return r; }
struct EpiF32 {
    static constexpr int ID = 2; static constexpr bool PERM = false, AFTER_DRAIN = false;
    float* C; int ldc;
    __device__ __forceinline__ void operator()(const f32x4 (&acc)[2][2][4][2], const Unit& u, int wr, int wc, int fr, int fq) const {
        const int row0 = u.pm * BM + wr * 64 + fr, col0 = u.pn * BM + wc * 32 + 4 * fq;
#pragma unroll
        for (int ai = 0; ai < 2; ++ai)
#pragma unroll
            for (int m = 0; m < 4; ++m) { float* rowp = C + (size_t)(row0 + ai * HALF + m * 16) * ldc + col0;
#pragma unroll
                for (int bj = 0; bj < 2; ++bj)
#pragma unroll
                    for (int n = 0; n < 2; ++n) *(f32x4*)(rowp + bj * HALF + n * 16) = acc[ai][bj][m][n]; }
    }
    __device__ __forceinline__ void fused(f32x4 (&)[2][2][4][2], const Unit&, int, int, int, int, PG8_LAS unsigned char*, int, int) const {}
};
template <int ACT  > struct EpiBf16 {
    static constexpr int ID = ACT; static constexpr bool PERM = true, AFTER_DRAIN = false;
    bf16_t* O; int ldc;
    __device__ __forceinline__ void operator()(const f32x4 (&acc)[2][2][4][2], const Unit& u, int wr, int wc, int fr, int fq) const {
        const int row0 = u.pm * BM + wr * 64 + fr; const int col0 = u.pn * BM + wc * 32 + 8 * fq;
#pragma unroll
        for (int ai = 0; ai < 2; ++ai)
#pragma unroll
            for (int m = 0; m < 4; ++m) { bf16_t* rowp = O + (size_t)(row0 + ai * HALF + m * 16) * ldc + col0;
#pragma unroll
                for (int bj = 0; bj < 2; ++bj) { f32x4 v0 = acc[ai][bj][m][0], v1 = acc[ai][bj][m][1];
                    if (ACT == 1) {
#pragma unroll
                        for (int j = 0; j < 4; ++j) { const float a = fmaxf(v0[j], 0.f), b = fmaxf(v1[j], 0.f); v0[j] = a * a; v1[j] = b * b; } }
                    u32x4 w; w.x = cvt_pk_bf16(v0[0], v0[1]); w.y = cvt_pk_bf16(v0[2], v0[3]); w.z = cvt_pk_bf16(v1[0], v1[1]); w.w = cvt_pk_bf16(v1[2], v1[3]);
                    *(u32x4*)(rowp + bj * HALF) = w; } }
    }
    __device__ __forceinline__ void fused(f32x4 (&)[2][2][4][2], const Unit&, int, int, int, int, PG8_LAS unsigned char*, int, int) const {}
};

struct EpiBf16Rope {
    static constexpr int ID = 0; static constexpr bool PERM = true, AFTER_DRAIN = false;
    bf16_t* O; int ldc; const float* rope; int head_lo, head_hi;
    __device__ __forceinline__ static float rot(float x, float c, float s, int hi) {
        auto rr = __builtin_amdgcn_permlane32_swap(__float_as_uint(x), __float_as_uint(x), false, false);
        const float y = __uint_as_float(hi ? rr[0] : rr[1]);
        return x * c + y * (hi ? s : -s);
    }
    __device__ __forceinline__ void operator()(const f32x4 (&acc)[2][2][4][2], const Unit& u, int wr, int wc, int fr, int fq) const {
        const int row0 = u.pm * BM + wr * 64 + fr; const int col0 = u.pn * BM + wc * 32 + 8 * fq;
        const int h0 = 2 * u.pn, h1 = h0 + 1, hi = fq >> 1;
        const bool r0 = (wc == 0) && h0 >= head_lo && h0 < head_hi, r1 = (wc == 0) && h1 >= head_lo && h1 < head_hi;
#pragma unroll
        for (int ai = 0; ai < 2; ++ai)
#pragma unroll
            for (int m = 0; m < 4; ++m) { const int row = row0 + ai * HALF + m * 16; bf16_t* rowp = O + (size_t)row * ldc + col0;
                const f32x4* tp = (const f32x4*)(rope + ((size_t)row * 16 + 8 * (fq & 1)) * 2);
#pragma unroll
                for (int bj = 0; bj < 2; ++bj) { f32x4 v0 = acc[ai][bj][m][0], v1 = acc[ai][bj][m][1];
                    if (bj == 0 ? r0 : r1) {
                        { const f32x4 t0 = tp[0], t1 = tp[1];
                          v0[0] = rot(v0[0], t0[0], t0[1], hi); v0[1] = rot(v0[1], t0[2], t0[3], hi); v0[2] = rot(v0[2], t1[0], t1[1], hi); v0[3] = rot(v0[3], t1[2], t1[3], hi); }
                        { const f32x4 t2 = tp[2], t3 = tp[3];
                          v1[0] = rot(v1[0], t2[0], t2[1], hi); v1[1] = rot(v1[1], t2[2], t2[3], hi); v1[2] = rot(v1[2], t3[0], t3[1], hi); v1[3] = rot(v1[3], t3[2], t3[3], hi); } }
                    u32x4 w; w.x = cvt_pk_bf16(v0[0], v0[1]); w.y = cvt_pk_bf16(v0[2], v0[3]); w.z = cvt_pk_bf16(v1[0], v1[1]); w.w = cvt_pk_bf16(v1[2], v1[3]);
                    *(u32x4*)(rowp + bj * HALF) = w; } }
    }
};

template <class Epi, class Sched, bool ALIGN_EPI = false, bool SP2 = false>
__device__ __forceinline__ void gemm_phase(PG8_LAS unsigned char* lds, const Gemm g, const Sched& S, const Epi& E, int wv) {
    const int tid = opaque_tid(wv), wid = __builtin_amdgcn_readfirstlane(tid >> 6), lane = tid & 63, wr = wid >> 2, wc = wid & 3, fr = lane & 15, fq = lane >> 4;
    const int K = g.K, nt = K / BK;
    unsigned voffA[2], voffB[2];
#pragma unroll
    for (int i = 0; i < 2; ++i) { int R, C; stage_rc(tid * 16 + i * 8192, R, C); const int Rb = Epi::PERM ? ((R & ~31) + perm32(R & 31)) : R;
        voffA[i] = (unsigned)(R * K + C) * 2u; voffB[i] = (unsigned)(Rb * K + C) * 2u; }
    const size_t kstep = (size_t)(BK * 2);
    const size_t hstep = (size_t)HALF * K * 2;
    const size_t tstep = 2 * hstep;
    const unsigned ldsw = (unsigned)wid * 1024u;
    const int aoff = lds_byte(wr * 64 + fr, fq * 8), boff = lds_byte(wc * 32 + fr, fq * 8);
#define PG8_SA(b, h) (((b) * 2 + (h)) * HTB)
#define PG8_SB(b, h) ((4 + (b) * 2 + (h)) * HTB)
#define PG8_STAGE(bufoff, gbase, voff) do { _Pragma("unroll") for (int _i = 0; _i < 2; ++_i) \
        __builtin_amdgcn_global_load_lds((const unsigned*)((const char*)(gbase) + (voff)[_i]), (PG8_LAS unsigned*)(lds + (bufoff) + ldsw + _i * 8192), 16, 0, 0); } while (0)
#define PG8_LDA(dst, b, h) do { _Pragma("unroll") for (int m = 0; m < 4; ++m) _Pragma("unroll") for (int k = 0; k < 2; ++k) dst[m][k] = *(const PG8_LAS bf16x8*)(lds + PG8_SA(b, h) + aoff + m * 2048 + k * 1024); } while (0)
#define PG8_LDB(dst, b, h) do { _Pragma("unroll") for (int n = 0; n < 2; ++n) _Pragma("unroll") for (int k = 0; k < 2; ++k) dst[n][k] = *(const PG8_LAS bf16x8*)(lds + PG8_SB(b, h) + boff + n * 2048 + k * 1024); } while (0)
#define PG8_MMA(ai, bj, At, Bt) do { __builtin_amdgcn_s_setprio(1); _Pragma("unroll") for (int m = 0; m < 4; ++m) _Pragma("unroll") for (int n = 0; n < 2; ++n) _Pragma("unroll") for (int k = 0; k < 2; ++k) \
        acc[ai][bj][m][n] = __builtin_amdgcn_mfma_f32_16x16x32_bf16(Bt[n][k], At[m][k], acc[ai][bj][m][n], 0, 0, 0); __builtin_amdgcn_s_setprio(0); } while (0)
#define PG8_WAIT_V(n) asm volatile("s_waitcnt vmcnt(" #n ")" ::: "memory")
#define PG8_WAIT_L(n) asm volatile("s_waitcnt lgkmcnt(" #n ")" ::: "memory")
#define PG8_BAR __builtin_amdgcn_s_barrier()
#define PG8_SCHED __builtin_amdgcn_sched_barrier(0)
    Unit cur, nxt; int ui = 0;
    if (!S.next(0, cur)) return;
    f32x4 acc[2][2][4][2];
#pragma unroll
    for (int a = 0; a < 2; ++a)
#pragma unroll
        for (int b = 0; b < 2; ++b)
#pragma unroll
            for (int m = 0; m < 4; ++m)
#pragma unroll
                for (int n = 0; n < 2; ++n) acc[a][b][m][n] = (f32x4){0.f, 0.f, 0.f, 0.f};
    bf16x8 At[4][2], B0[2][2], B1[2][2];
    const char* cA = (const char*)g.A + (size_t)cur.pm * tstep; const char* cB = (const char*)g.Bt + (size_t)cur.pn * tstep;
    S.a_ready(cur);
    if constexpr (SP2) {
        PG8_STAGE(PG8_SB(0, 0), cB, voffB); PG8_STAGE(PG8_SB(0, 1), cB + hstep, voffB); PG8_STAGE(PG8_SA(0, 0), cA, voffA); PG8_STAGE(PG8_SA(0, 1), cA + hstep, voffA);
        if (wr == 1) PG8_BAR;
        PG8_WAIT_V(2); PG8_BAR;
        PG8_STAGE(PG8_SB(1, 0), cB + kstep, voffB); PG8_STAGE(PG8_SA(1, 0), cA + kstep, voffA); PG8_STAGE(PG8_SB(1, 1), cB + hstep + kstep, voffB);
        PG8_WAIT_V(6); PG8_BAR;
    } else {
        PG8_STAGE(PG8_SB(0, 0), cB, voffB); PG8_STAGE(PG8_SA(0, 0), cA, voffA); PG8_STAGE(PG8_SB(0, 1), cB + hstep, voffB); PG8_STAGE(PG8_SA(0, 1), cA + hstep, voffA);
        if (wr == 1) PG8_BAR;
        PG8_WAIT_V(4); PG8_BAR;
        PG8_STAGE(PG8_SB(1, 0), cB + kstep, voffB); PG8_STAGE(PG8_SA(1, 0), cA + kstep, voffA); PG8_STAGE(PG8_SB(1, 1), cB + hstep + kstep, voffB);
        PG8_WAIT_V(6); PG8_BAR;
    }
    for (;;) {
        const bool has_next = S.next(ui + 1, nxt);
        const char* nA = has_next ? (const char*)g.A + (size_t)nxt.pm * tstep : cA; const char* nB = has_next ? (const char*)g.Bt + (size_t)nxt.pn * tstep : cB;
        for (int t = 0; t < nt; t += 2) {
            const bool last = (t == nt - 2);
            const char* a1 = cA + (size_t)(t + 1) * kstep;
            const char* a2 = last ? nA : cA + (size_t)(t + 2) * kstep; const char* b2 = last ? nB : cB + (size_t)(t + 2) * kstep;
            const char* a3 = a2 + kstep; const char* b3 = b2 + kstep;
            if (last && has_next) S.a_ready(nxt);
            if constexpr (SP2) {
            PG8_LDB(B0, 0, 0); PG8_LDB(B1, 0, 1); PG8_SCHED; PG8_LDA(At, 0, 0); PG8_STAGE(PG8_SA(1, 1), a1 + hstep, voffA);
            PG8_WAIT_V(8); PG8_WAIT_L(0); PG8_BAR; PG8_MMA(0, 0, At, B0); PG8_MMA(0, 1, At, B1); PG8_BAR; PG8_SCHED;
            PG8_LDA(At, 0, 1); PG8_STAGE(PG8_SB(0, 0), b2, voffB); PG8_STAGE(PG8_SB(0, 1), b2 + hstep, voffB); PG8_STAGE(PG8_SA(0, 0), a2, voffA);
            PG8_WAIT_V(8); PG8_WAIT_L(0); PG8_BAR; PG8_MMA(1, 0, At, B0); PG8_MMA(1, 1, At, B1); PG8_BAR; PG8_SCHED;
            PG8_LDB(B0, 1, 0); PG8_LDB(B1, 1, 1); PG8_SCHED; PG8_LDA(At, 1, 0); PG8_STAGE(PG8_SA(0, 1), a2 + hstep, voffA);
            PG8_WAIT_V(8); PG8_WAIT_L(0); PG8_BAR; PG8_MMA(0, 0, At, B0); PG8_MMA(0, 1, At, B1); PG8_BAR; PG8_SCHED;
            PG8_LDA(At, 1, 1); PG8_STAGE(PG8_SB(1, 0), b3, voffB); PG8_STAGE(PG8_SB(1, 1), b3 + hstep, voffB); PG8_STAGE(PG8_SA(1, 0), a3, voffA);
            PG8_WAIT_V(8); PG8_WAIT_L(0); PG8_BAR; PG8_MMA(1, 0, At, B0); PG8_MMA(1, 1, At, B1); PG8_BAR; PG8_SCHED;
            } else {
            PG8_LDB(B0, 0, 0); PG8_SCHED; PG8_LDA(At, 0, 0); PG8_STAGE(PG8_SA(1, 1), a1 + hstep, voffA);
            PG8_WAIT_L(8); PG8_BAR; PG8_WAIT_L(0); PG8_MMA(0, 0, At, B0); PG8_BAR; PG8_SCHED;
            PG8_LDB(B1, 0, 1); PG8_STAGE(PG8_SB(0, 0), b2, voffB);
            PG8_BAR; PG8_WAIT_L(0); PG8_MMA(0, 1, At, B1); PG8_BAR;
            PG8_LDA(At, 0, 1); PG8_STAGE(PG8_SA(0, 0), a2, voffA);
            PG8_BAR; PG8_WAIT_L(0); PG8_MMA(1, 0, At, B0); PG8_BAR; PG8_SCHED;
            PG8_STAGE(PG8_SB(0, 1), b2 + hstep, voffB);
            PG8_WAIT_V(6); PG8_BAR; PG8_MMA(1, 1, At, B1); PG8_BAR;
            PG8_LDB(B0, 1, 0); PG8_SCHED; PG8_LDA(At, 1, 0); PG8_STAGE(PG8_SA(0, 1), a2 + hstep, voffA);
            PG8_WAIT_L(8); PG8_BAR; PG8_WAIT_L(0); PG8_MMA(0, 0, At, B0); PG8_BAR; PG8_SCHED;
            PG8_LDB(B1, 1, 1); PG8_STAGE(PG8_SB(1, 0), b3, voffB);
            PG8_BAR; PG8_WAIT_L(0); PG8_MMA(0, 1, At, B1); PG8_BAR;
            PG8_LDA(At, 1, 1); PG8_STAGE(PG8_SA(1, 0), a3, voffA);
            PG8_BAR; PG8_WAIT_L(0); PG8_MMA(1, 0, At, B0); PG8_BAR; PG8_SCHED;
            PG8_STAGE(PG8_SB(1, 1), b3 + hstep, voffB);
            PG8_WAIT_V(6); PG8_BAR; PG8_MMA(1, 1, At, B1); PG8_BAR;
            }
        }
        if constexpr (ALIGN_EPI) { if (wr == 0) PG8_BAR; }
        if constexpr (!Epi::AFTER_DRAIN) { E(acc, cur, wr, wc, fr, fq); S.done(cur); }
        if (!has_next) break;
#pragma unroll
        for (int a = 0; a < 2; ++a)
#pragma unroll
            for (int b = 0; b < 2; ++b)
#pragma unroll
                for (int m = 0; m < 4; ++m)
#pragma unroll
                    for (int n = 0; n < 2; ++n) acc[a][b][m][n] = (f32x4){0.f, 0.f, 0.f, 0.f};
        cur = nxt; cA = nA; cB = nB; ++ui;
        if constexpr (ALIGN_EPI) { if (wr == 1) PG8_BAR; }
    }
    PG8_WAIT_V(0);
    if constexpr (!ALIGN_EPI) { if (wr == 0) PG8_BAR; }
    PG8_BAR;
    if constexpr (Epi::AFTER_DRAIN) { E.fused(acc, cur, wr, wc, fr, fq, lds, wid, lane); S.done(cur); }
#undef PG8_SA
#undef PG8_SB
#undef PG8_STAGE
#undef PG8_LDA
#undef PG8_LDB
#undef PG8_MMA
#undef PG8_WAIT_V
#undef PG8_WAIT_L
#undef PG8_BAR
#undef PG8_SCHED
}
}
namespace att {
typedef unsigned short u16;
constexpr int   D = 128, NW = 8, QBLK = 32, KVBLK = 64;
constexpr float SCALE = 0.088388347648318440f;
constexpr float THR = 8.f;
constexpr size_t SHM_V = KVBLK * D * 2, SHM_K = KVBLK * D * 2, SHM_ATTN = 2 * SHM_V + 2 * SHM_K + NW * 64 * 4;
using bf16x8 = __attribute__((ext_vector_type(8))) short;
using s16x4  = __attribute__((ext_vector_type(4))) short;
using f32x16 = __attribute__((ext_vector_type(16))) float;
using u32x4  = __attribute__((ext_vector_type(4))) unsigned;
#define KSWZ(row, colB) ((row) * 256 + ((colB) ^ (((row) & 7) << 4)))
#define SBAR() __builtin_amdgcn_sched_barrier(0)
__device__ __forceinline__ int crow(int r, int hi) { return (r & 3) + 8 * (r >> 2) + 4 * hi; }
__device__ __forceinline__ unsigned cvtpk(float lo, float hi) {
  unsigned r; asm volatile("v_cvt_pk_bf16_f32 %0, %1, %2" : "=v"(r) : "v"(lo), "v"(hi)); return r;
}
__device__ __forceinline__ bf16x8 ld8(const u16* p) { return *reinterpret_cast<const bf16x8*>(p); }

__device__ __forceinline__ void partialSM(f32x16& p0, f32x16& p1, float& m_reg, float& mn, float& alpha) {
  constexpr float C = SCALE * 1.4426950408889634f;
  float pmax = p0[0]; for (int r = 1; r < 16; ++r) pmax = fmaxf(pmax, p0[r]); for (int r = 0; r < 16; ++r) pmax = fmaxf(pmax, p1[r]);
  { auto rr = __builtin_amdgcn_permlane32_swap(__float_as_uint(pmax), __float_as_uint(pmax), false, false);
    pmax = fmaxf(__uint_as_float(rr[0]), __uint_as_float(rr[1])); }
  if (__builtin_expect(__all(pmax - m_reg <= THR / SCALE), 1)) { mn = m_reg; alpha = 1.f; }
  else { mn = fmaxf(m_reg, pmax); alpha = __builtin_amdgcn_exp2f((m_reg - mn) * C); m_reg = mn; }
  float mnC = -mn * C;
  for (int r = 0; r < 16; ++r) p0[r] = fmaf(p0[r], C, mnC); for (int r = 0; r < 16; ++r) p1[r] = fmaf(p1[r], C, mnC);
  for (int r = 0; r < 16; ++r) p0[r] = __builtin_amdgcn_exp2f(p0[r]);
}
__device__ __forceinline__ void finishSM(f32x16& p0, f32x16& p1, float alpha, float& l_reg, bf16x8& pa0, bf16x8& pa1, bf16x8& pa2, bf16x8& pa3) {
  for (int r = 0; r < 16; ++r) p1[r] = __builtin_amdgcn_exp2f(p1[r]);
  float ps = 0; for (int r = 0; r < 16; ++r) ps += p0[r]; for (int r = 0; r < 16; ++r) ps += p1[r];
  { auto rr = __builtin_amdgcn_permlane32_swap(__float_as_uint(ps), __float_as_uint(ps), false, false);
    ps = __uint_as_float(rr[0]) + __uint_as_float(rr[1]); }
  l_reg = l_reg * alpha + ps;
#define PK4(P, BASE, OUT) do { unsigned a0 = cvtpk(P[BASE + 0], P[BASE + 1]), a1 = cvtpk(P[BASE + 2], P[BASE + 3]);   \
    unsigned b0 = cvtpk(P[BASE + 4], P[BASE + 5]), b1 = cvtpk(P[BASE + 6], P[BASE + 7]);                              \
    auto r0 = __builtin_amdgcn_permlane32_swap(a0, b0, false, false); auto r1 = __builtin_amdgcn_permlane32_swap(a1, b1, false, false); \
    u32x4 w = {r0[0], r1[0], r0[1], r1[1]}; OUT = *reinterpret_cast<bf16x8*>(&w); } while (0)
  PK4(p0, 0, pa0); PK4(p0, 8, pa1); PK4(p1, 0, pa2); PK4(p1, 8, pa3);
#undef PK4
}
__device__ __forceinline__ void qkt(f32x16& p0, f32x16& p1, const char* Ks, const bf16x8* qr, int r32, int hi) {
  p0 = f32x16{}; p1 = f32x16{};
  for (int d0 = 0; d0 < 8; ++d0) { int cb = (d0 * 16 + hi * 8) * 2;
    bf16x8 b0 = *reinterpret_cast<const bf16x8*>(Ks + KSWZ(r32, cb));
    bf16x8 b1 = *reinterpret_cast<const bf16x8*>(Ks + KSWZ(32 + r32, cb));
    p0 = __builtin_amdgcn_mfma_f32_32x32x16_bf16(b0, qr[d0], p0, 0, 0, 0);
    p1 = __builtin_amdgcn_mfma_f32_32x32x16_bf16(b1, qr[d0], p1, 0, 0, 0); }
}
__device__ __forceinline__ int v_st(int k, int c) { const int kk = (k & ~0xC) | ((k & 4) << 1) | ((k & 8) >> 1); return ((kk >> 3) * 4 + (c >> 5)) * 512 + ((kk & 7) * 32 + (c & 31)) * 2; }
__device__ __forceinline__ int v_rd_base(int lane) { return ((lane & 3) << 3) | (((lane >> 2) & 3) << 6) | (((lane >> 4) & 1) << 5) | (((lane >> 5) & 1) << 8); }
constexpr int v_rd_off(int d0, int ks, int half) { return d0 * 512 + ks * 4096 + half * 2048; }
template <int OFF> __device__ __forceinline__ s16x4 tr_read(int vb) {
  s16x4 r; asm volatile("ds_read_b64_tr_b16 %0, %1 offset:%2" : "=&v"(r) : "v"(vb), "i"(OFF) : "memory"); return r;
}
template <int D0> __device__ __forceinline__ void pv_one(f32x16& od, int vb, bf16x8 pa0, bf16x8 pa1, bf16x8 pa2, bf16x8 pa3) {
  const s16x4 l0 = tr_read<v_rd_off(D0, 0, 0)>(vb), h0 = tr_read<v_rd_off(D0, 0, 1)>(vb), l1 = tr_read<v_rd_off(D0, 1, 0)>(vb), h1 = tr_read<v_rd_off(D0, 1, 1)>(vb);
  const s16x4 l2 = tr_read<v_rd_off(D0, 2, 0)>(vb), h2 = tr_read<v_rd_off(D0, 2, 1)>(vb), l3 = tr_read<v_rd_off(D0, 3, 0)>(vb), h3 = tr_read<v_rd_off(D0, 3, 1)>(vb);
  asm volatile("s_waitcnt lgkmcnt(0)" ::: "memory"); SBAR();
#define PK(L, H) (bf16x8){L[0], L[1], L[2], L[3], H[0], H[1], H[2], H[3]}
  od = __builtin_amdgcn_mfma_f32_32x32x16_bf16(pa0, PK(l0, h0), od, 0, 0, 0);
  od = __builtin_amdgcn_mfma_f32_32x32x16_bf16(pa1, PK(l1, h1), od, 0, 0, 0);
  od = __builtin_amdgcn_mfma_f32_32x32x16_bf16(pa2, PK(l2, h2), od, 0, 0, 0);
  od = __builtin_amdgcn_mfma_f32_32x32x16_bf16(pa3, PK(l3, h3), od, 0, 0, 0);
#undef PK
}
__device__ __forceinline__ void pv_d0(f32x16* o, int vb, bf16x8 pa0, bf16x8 pa1, bf16x8 pa2, bf16x8 pa3) {
  pv_one<0>(o[0], vb, pa0, pa1, pa2, pa3); pv_one<1>(o[1], vb, pa0, pa1, pa2, pa3); pv_one<2>(o[2], vb, pa0, pa1, pa2, pa3); pv_one<3>(o[3], vb, pa0, pa1, pa2, pa3);
}

struct ModNone { __device__ __forceinline__ void operator()(f32x16&, f32x16&, int) const {}
  __device__ __forceinline__ bool active(int) const { return true; } };
struct ModSWA { int qrel, hi, qw  ;
  __device__ __forceinline__ bool active(int t) const { return 64 * t <= qw + 159 && 64 * t + 191 >= qw; }
  __device__ __forceinline__ void operator()(f32x16& p0, f32x16& p1, int t) const {
    const int x = qrel - t * 64 - 4 * hi, lo = x - 128, up = x + 128; const float ninf = -__builtin_inff();
#pragma unroll
    for (int r = 0; r < 16; ++r) { const int kc = (r & 3) + 8 * (r >> 2);
      p0[r] = (lo <= kc && up >= kc) ? p0[r] : ninf; p1[r] = (lo <= kc + 32 && up >= kc + 32) ? p1[r] : ninf; }
  } };
struct ModNA { int kr0, qi, qj, rs, cs, hi; const __attribute__((address_space(3))) float* tab;
  __device__ __forceinline__ bool active(int t) const { const int kr = kr0 + t; return kr >= rs && kr < rs + 8; }
  __device__ __forceinline__ void operator()(f32x16& p0, f32x16& p1, int t) const {
    const int kr = kr0 + t; const float ninf = -__builtin_inff();
    if (kr < rs || kr >= rs + 8) {
#pragma unroll
      for (int r = 0; r < 16; ++r) { p0[r] = ninf; p1[r] = ninf; }
    } else {
      const __attribute__((address_space(3))) float* trow = tab + ((kr - qi + 7) * 31 + 15 - qj + 4 * hi);
      const int c0 = 4 * hi - cs;
#pragma unroll
      for (int r = 0; r < 16; ++r) { const int kc = (r & 3) + 8 * (r >> 2); const int ia = kc + c0, ib = ia + 32;
        const float ba = trow[kc], bb = trow[kc + 32];
        p0[r] = ((unsigned)ia < 16u) ? p0[r] + ba : ninf; p1[r] = ((unsigned)ib < 16u) ? p1[r] + bb : ninf; }
    }
  } };

template <int LDQ, int LDK, int LDO, class Mod>
__device__ __forceinline__ void attn_body(const u16* __restrict__ Qb, const u16* __restrict__ Kh, const u16* __restrict__ Vh,
                                          u16* __restrict__ Ob, int NT, char* lds, int wv, const Mod& mod, float m_init, float l_init) {
  const int tid = opaque_tid(wv), wid = tid >> 6, lane = tid & 63, r32 = lane & 31, hi = lane >> 5;
  char* V_lds = lds; char* K_lds = lds + 2 * SHM_V;
  float* ws = (float*)(lds + 2 * SHM_V + 2 * SHM_K) + wid * 64; float* li_l = ws; float* al_l = ws + 32;
  float m_reg = m_init, l_reg = l_init; f32x16 o[4] = {}; bf16x8 qr[8];
  const u16* Qw = Qb + (long)(wid * QBLK + r32) * LDQ + hi * 8;
#pragma unroll
  for (int d0 = 0; d0 < 8; ++d0) qr[d0] = ld8(Qw + d0 * 16);
  const int sr = tid >> 4, sc = (tid & 15) * 8, vst0 = v_st(sr, sc), vst1 = v_st(32 + sr, sc);
  const int vb0 = (int)(uintptr_t)V_lds + v_rd_base(lane);
  struct { bf16x8 vs0, vs1, ks0, ks1; } sr_[1];
#define SLOAD(i, k0) do { sr_[i].vs0 = ld8(&Vh[(long)((k0) + sr) * LDK + sc]); sr_[i].vs1 = ld8(&Vh[(long)((k0) + 32 + sr) * LDK + sc]); \
    sr_[i].ks0 = ld8(&Kh[(long)((k0) + sr) * LDK + sc]); sr_[i].ks1 = ld8(&Kh[(long)((k0) + 32 + sr) * LDK + sc]); } while (0)
#define SWRITE(b, i) do { *(bf16x8*)(V_lds + (b) * SHM_V + vst0) = sr_[i].vs0;          \
    *(bf16x8*)(V_lds + (b) * SHM_V + vst1) = sr_[i].vs1; int kc = sc * 2;               \
    *(bf16x8*)(K_lds + (b) * SHM_K + KSWZ(sr, kc)) = sr_[i].ks0;                       \
    *(bf16x8*)(K_lds + (b) * SHM_K + KSWZ(32 + sr, kc)) = sr_[i].ks1; } while (0)
#define SWAIT() asm volatile("s_waitcnt vmcnt(0)" ::: "memory")
#define RESC(a) do { if (__any((a) < 1.f)) { if (hi == 0) al_l[r32] = (a); asm volatile("s_waitcnt lgkmcnt(0)" ::: "memory"); \
    for (int d = 0; d < 4; ++d) for (int r = 0; r < 16; ++r) o[d][r] *= al_l[crow(r, hi)]; } } while (0)
  f32x16 pA0, pA1, pB0, pB1; float mnA, mnB, alA, alB; bf16x8 pa0, pa1, pa2, pa3;
  constexpr int SE = 0, SO = 0;
  SLOAD(SE, 0); asm volatile("s_waitcnt vmcnt(0)" ::: "memory"); SWRITE(0, SE); __syncthreads();
  if (mod.active(0)) qkt(pA0, pA1, K_lds, qr, r32, hi); else { pA0 = f32x16{}; pA1 = f32x16{}; }
  mod(pA0, pA1, 0); partialSM(pA0, pA1, m_reg, mnA, alA);
  SLOAD(SO, KVBLK);
  SWAIT(); SWRITE(1, SO); __syncthreads();
  for (int j = 1; j + 1 < NT; j += 2) {
    SBAR(); if (mod.active(j)) qkt(pB0, pB1, K_lds + SHM_K, qr, r32, hi); else { pB0 = f32x16{}; pB1 = f32x16{}; }
    finishSM(pA0, pA1, alA, l_reg, pa0, pa1, pa2, pa3); SBAR();
    SLOAD(SO, (j + 1) * KVBLK); SBAR();
    if (mod.active(j - 1)) pv_d0(o, vb0, pa0, pa1, pa2, pa3); mod(pB0, pB1, j); partialSM(pB0, pB1, m_reg, mnB, alB);
    __syncthreads(); SWAIT(); SWRITE(0, SE);
    RESC(alB); __syncthreads();
    SBAR(); if (mod.active(j + 1)) qkt(pA0, pA1, K_lds, qr, r32, hi); else { pA0 = f32x16{}; pA1 = f32x16{}; }
    finishSM(pB0, pB1, alB, l_reg, pa0, pa1, pa2, pa3); SBAR();
    SLOAD(SE, (j + 2) * KVBLK); SBAR();
    if (mod.active(j)) pv_d0(o, vb0 + (int)SHM_V, pa0, pa1, pa2, pa3); mod(pA0, pA1, j + 1); partialSM(pA0, pA1, m_reg, mnA, alA);
    __syncthreads(); SWAIT(); SWRITE(1, SO);
    RESC(alA); __syncthreads();
  }
  SBAR(); if (mod.active(NT - 1)) qkt(pB0, pB1, K_lds + SHM_K, qr, r32, hi); else { pB0 = f32x16{}; pB1 = f32x16{}; }
  finishSM(pA0, pA1, alA, l_reg, pa0, pa1, pa2, pa3); SBAR();
  if (mod.active(NT - 2)) pv_d0(o, vb0, pa0, pa1, pa2, pa3); mod(pB0, pB1, NT - 1); partialSM(pB0, pB1, m_reg, mnB, alB);
  __syncthreads(); RESC(alB);
  finishSM(pB0, pB1, alB, l_reg, pa0, pa1, pa2, pa3); SBAR();
  if (mod.active(NT - 1)) pv_d0(o, vb0 + (int)SHM_V, pa0, pa1, pa2, pa3);
  if (hi == 0) li_l[r32] = l_reg; asm volatile("s_waitcnt lgkmcnt(0)" ::: "memory");
  float rli[16];
#pragma unroll
  for (int r = 0; r < 16; ++r) rli[r] = __builtin_amdgcn_rcpf(li_l[crow(r, hi)]);
  u16* Ow = Ob + (long)(wid * QBLK) * LDO;
#pragma unroll
  for (int r = 0; r < 16; ++r) { int orow = crow(r, hi);
#pragma unroll
    for (int d0 = 0; d0 < 4; ++d0) Ow[(long)orow * LDO + d0 * 32 + r32] = (u16)cvtpk(o[d0][r] * rli[r], 0.f); }
  __syncthreads();
#undef SLOAD
#undef SWRITE
#undef SWAIT
#undef RESC
}
#define PVR(HB, S) const s16x4 S##l0 = tr_read<v_rd_off((HB) >> 1, 2 * ((HB) & 1), 0)>(vb), S##h0 = tr_read<v_rd_off((HB) >> 1, 2 * ((HB) & 1), 1)>(vb), \
    S##l1 = tr_read<v_rd_off((HB) >> 1, 2 * ((HB) & 1) + 1, 0)>(vb), S##h1 = tr_read<v_rd_off((HB) >> 1, 2 * ((HB) & 1) + 1, 1)>(vb)
#define PVK(L, H) (bf16x8){L[0], L[1], L[2], L[3], H[0], H[1], H[2], H[3]}
#define PVM(HB, S, PA, PB) do { o[(HB) >> 1] = __builtin_amdgcn_mfma_f32_32x32x16_bf16(PA, PVK(S##l0, S##h0), o[(HB) >> 1], 0, 0, 0); \
    o[(HB) >> 1] = __builtin_amdgcn_mfma_f32_32x32x16_bf16(PB, PVK(S##l1, S##h1), o[(HB) >> 1], 0, 0, 0); } while (0)
#define PVW(N) do { asm volatile("s_waitcnt lgkmcnt(" #N ")" ::: "memory"); SBAR(); } while (0)
__device__ __forceinline__ void pv_pipe(f32x16* o, int vb, bf16x8 pa0, bf16x8 pa1, bf16x8 pa2, bf16x8 pa3) {
  PVR(0, a); PVR(1, b); PVR(2, c);
  PVW(8); PVM(0, a, pa0, pa1); PVR(3, d);
  PVW(8); PVM(1, b, pa2, pa3); PVR(4, e);
  PVW(8); PVM(2, c, pa0, pa1); PVR(5, f);
  PVW(8); PVM(3, d, pa2, pa3); PVR(6, g);
  PVW(8); PVM(4, e, pa0, pa1); PVR(7, h);
  PVW(8); PVM(5, f, pa2, pa3);
  PVW(4); PVM(6, g, pa0, pa1);
  PVW(0); PVM(7, h, pa2, pa3);
}
#undef PVR
#undef PVK
#undef PVM
#undef PVW
__device__ __forceinline__ void qkt_half(f32x16& p, const char* Ks, const bf16x8* qr, int krow, int hi) {
  p = f32x16{};
  for (int d0 = 0; d0 < 8; ++d0) { int cb = (d0 * 16 + hi * 8) * 2;
    bf16x8 b = *reinterpret_cast<const bf16x8*>(Ks + KSWZ(krow, cb));
    p = __builtin_amdgcn_mfma_f32_32x32x16_bf16(b, qr[d0], p, 0, 0, 0); }
}
__device__ __forceinline__ float halfmax(const f32x16& p) {
  float pmax = p[0]; for (int r = 1; r < 16; ++r) pmax = fmaxf(pmax, p[r]);
  auto rr = __builtin_amdgcn_permlane32_swap(__float_as_uint(pmax), __float_as_uint(pmax), false, false);
  return fmaxf(__uint_as_float(rr[0]), __uint_as_float(rr[1]));
}
template <int LDQ, int LDK, int LDV, int LDO>
__device__ __forceinline__ void attn_dv256_body(const u16* __restrict__ Qb, const u16* __restrict__ Kh, const u16* __restrict__ Vh, u16* __restrict__ Ob, int NT, char* lds, int wv) {
  const int tid = opaque_tid(wv), wid = __builtin_amdgcn_readfirstlane(tid >> 6), lane = tid & 63, r32 = lane & 31, hi = lane >> 5;
  const int rg = wid >> 1, ch = wid & 1;
  char* K_lds = lds;
  char* V_lds = lds + 32768;
  char* PX = lds + 98304;
  float* MX = (float*)(lds + 135168);
  float* al_l = (float*)(lds + 139264) + wid * 64;
  float* LX = (float*)(lds + 141312);
  float m_reg = -1e30f, l_reg = 0.f; f32x16 o[4] = {}; bf16x8 qr[8];
  const u16* Qw = Qb + (long)(rg * 32 + r32) * LDQ + hi * 8;
#pragma unroll
  for (int d0 = 0; d0 < 8; ++d0) qr[d0] = ld8(Qw + d0 * 16);
  const int sr = tid >> 4, sc = (tid & 15) * 8, vst0 = v_st(sr, sc), vst1 = v_st(32 + sr, sc), kcb = sc * 2;
  const int vb0 = (int)(uintptr_t)V_lds + ch * 16384 + v_rd_base(lane);
  const int pxw = (wid * 2 * 64 + lane) * 16, px0 = ((wid & ~1) * 2 * 64 + lane) * 16;
  const int krow = 32 * ch + r32;
  bf16x8 ks0, ks1, vs0, vs1, vs2, vs3;
#define KLOAD(k0) do { ks0 = ld8(&Kh[(long)((k0) + sr) * LDK + sc]); ks1 = ld8(&Kh[(long)((k0) + 32 + sr) * LDK + sc]); } while (0)
#define VLOAD(k0) do { vs0 = ld8(&Vh[(long)((k0) + sr) * LDV + sc]); vs1 = ld8(&Vh[(long)((k0) + 32 + sr) * LDV + sc]); \
    vs2 = ld8(&Vh[(long)((k0) + sr) * LDV + 128 + sc]); vs3 = ld8(&Vh[(long)((k0) + 32 + sr) * LDV + 128 + sc]); } while (0)
#define KWRITE(b) do { *(bf16x8*)(K_lds + (b) * 16384 + KSWZ(sr, kcb)) = ks0; *(bf16x8*)(K_lds + (b) * 16384 + KSWZ(32 + sr, kcb)) = ks1; } while (0)
#define VWRITE(b) do { *(bf16x8*)(V_lds + (b) * 32768 + vst0) = vs0; *(bf16x8*)(V_lds + (b) * 32768 + vst1) = vs1; \
    *(bf16x8*)(V_lds + (b) * 32768 + 16384 + vst0) = vs2; *(bf16x8*)(V_lds + (b) * 32768 + 16384 + vst1) = vs3; } while (0)
#define RESC(a) do { if (__any((a) < 1.f)) { if (hi == 0) al_l[r32] = (a); asm volatile("s_waitcnt lgkmcnt(0)" ::: "memory"); \
    for (int d = 0; d < 4; ++d) for (int r = 0; r < 16; ++r) o[d][r] *= al_l[crow(r, hi)]; } } while (0)
#define PK4(P, BASE, OUT) do { unsigned a0 = cvtpk(P[BASE + 0], P[BASE + 1]), a1 = cvtpk(P[BASE + 2], P[BASE + 3]);   \
    unsigned b0 = cvtpk(P[BASE + 4], P[BASE + 5]), b1 = cvtpk(P[BASE + 6], P[BASE + 7]);                              \
    auto r0 = __builtin_amdgcn_permlane32_swap(a0, b0, false, false); auto r1 = __builtin_amdgcn_permlane32_swap(a1, b1, false, false); \
    u32x4 w = {r0[0], r1[0], r0[1], r1[1]}; OUT = *reinterpret_cast<bf16x8*>(&w); } while (0)
  KLOAD(0); asm volatile("s_waitcnt vmcnt(0)" ::: "memory"); KWRITE(0);
  KLOAD(64); asm volatile("s_waitcnt vmcnt(0)" ::: "memory"); KWRITE(1);
  if (2 < NT) KLOAD(128);
  VLOAD(0);
  __syncthreads();
  f32x16 pC, pN; float pmC, pmN = 0.f;
  qkt_half(pC, K_lds, qr, krow, hi);
  pmC = halfmax(pC); MX[(0 * 8 + wid) * 64 + lane] = pmC;
  __syncthreads();
  for (int t = 0; t < NT; ++t) {
    const int par = t & 1;
    if (t + 1 < NT) qkt_half(pN, K_lds + (par ^ 1) * 16384, qr, krow, hi);
    if (t >= 1) {
      const bf16x8 pa0 = *(const bf16x8*)(PX + (par ^ 1) * 16384 + px0), pa1 = *(const bf16x8*)(PX + (par ^ 1) * 16384 + px0 + 1024);
      const bf16x8 pa2 = *(const bf16x8*)(PX + (par ^ 1) * 16384 + px0 + 2048), pa3 = *(const bf16x8*)(PX + (par ^ 1) * 16384 + px0 + 3072);
      pv_pipe(o, vb0 + (par ^ 1) * 32768, pa0, pa1, pa2, pa3);
    }
    float alpha;
    {
      constexpr float C = SCALE * 1.4426950408889634f;
      const float pmP = MX[(par * 8 + (wid ^ 1)) * 64 + lane];
      const float pmax = fmaxf(pmC, pmP);
      float mn;
      if (__builtin_expect(__all(pmax - m_reg <= THR / SCALE), 1)) { mn = m_reg; alpha = 1.f; }
      else { mn = fmaxf(m_reg, pmax); alpha = __builtin_amdgcn_exp2f((m_reg - mn) * C); m_reg = mn; }
      const float mnC = -mn * C;
      for (int r = 0; r < 16; ++r) pC[r] = __builtin_amdgcn_exp2f(fmaf(pC[r], C, mnC));
      float ps = 0; for (int r = 0; r < 16; ++r) ps += pC[r];
      { auto rr = __builtin_amdgcn_permlane32_swap(__float_as_uint(ps), __float_as_uint(ps), false, false);
        ps = __uint_as_float(rr[0]) + __uint_as_float(rr[1]); }
      l_reg = l_reg * alpha + ps;
      bf16x8 fo0, fo1; PK4(pC, 0, fo0); PK4(pC, 8, fo1);
      *(bf16x8*)(PX + par * 16384 + pxw) = fo0; *(bf16x8*)(PX + par * 16384 + pxw + 1024) = fo1;
    }
    RESC(alpha);
    if (t + 1 < NT) { pmN = halfmax(pN); MX[((par ^ 1) * 8 + wid) * 64 + lane] = pmN; }
    asm volatile("s_waitcnt vmcnt(0)" ::: "memory");
    if (t + 2 < NT) KWRITE(par);
    VWRITE(par);
    if (t + 3 < NT) KLOAD((t + 3) * 64);
    if (t + 1 < NT) VLOAD((t + 1) * 64);
    __syncthreads();
    pC = pN; pmC = pmN;
  }
  {
    const int par = (NT - 1) & 1;
    const bf16x8 pa0 = *(const bf16x8*)(PX + par * 16384 + px0), pa1 = *(const bf16x8*)(PX + par * 16384 + px0 + 1024);
    const bf16x8 pa2 = *(const bf16x8*)(PX + par * 16384 + px0 + 2048), pa3 = *(const bf16x8*)(PX + par * 16384 + px0 + 3072);
    pv_pipe(o, vb0 + par * 32768, pa0, pa1, pa2, pa3);
  }
  LX[wid * 64 + lane] = l_reg;
  __syncthreads();
  const float ltot = l_reg + LX[(wid ^ 1) * 64 + lane];
  if (hi == 0) al_l[r32] = ltot; asm volatile("s_waitcnt lgkmcnt(0)" ::: "memory");
  float rli[16];
#pragma unroll
  for (int r = 0; r < 16; ++r) rli[r] = __builtin_amdgcn_rcpf(al_l[crow(r, hi)]);
  u16* Ow = Ob + (long)(rg * 32) * LDO + ch * 128;
#pragma unroll
  for (int r = 0; r < 16; ++r) { int orow = crow(r, hi);
#pragma unroll
    for (int d0 = 0; d0 < 4; ++d0) Ow[(long)orow * LDO + d0 * 32 + r32] = (u16)cvtpk(o[d0][r] * rli[r], 0.f); }
  __syncthreads();
#undef KLOAD
#undef VLOAD
#undef KWRITE
#undef VWRITE
#undef RESC
#undef PK4
}
}

#ifndef PROBE
#define PROBE 0
#endif
#ifndef EN_NA
#define EN_NA 1
#endif
#ifndef EN_SWA
#define EN_SWA 1
#endif
#ifndef EN_DIFF
#define EN_DIFF 1
#endif
#ifndef EN_MEM
#define EN_MEM 1
#endif
#ifndef EN_EPI
#define EN_EPI -1
#endif
#ifndef EN_GEMM
#define EN_GEMM 1
#endif
#define LAS __attribute__((address_space(3)))
typedef unsigned short bf16;
typedef unsigned v4u __attribute__((ext_vector_type(4)));
typedef unsigned v2u __attribute__((ext_vector_type(2)));
typedef float f32x4 __attribute__((ext_vector_type(4)));
constexpr int NWAVES = 8, NTHREADS = 512;
constexpr int S_ = 8192, DM = 2048, MEMLEN = 256, DFF = 8192;
constexpr int EVEN_IN = 4608, ODD_IN = 6144, MEMW = 512;
constexpr float EPS = 1e-6f;
constexpr float LAMBDA_INIT1 = 0.35550906f;
constexpr int LDS_BYTES = 147456;
constexpr int NA_TAB_OFF = 67584 + 512;
constexpr size_t MiB = 1u << 20;
constexpr size_t WS_WIN0 = 0, WS_WOUT0 = 18 * MiB, WS_WIN1 = 26 * MiB, WS_WOUT1 = 50 * MiB, WS_WQ = 58 * MiB  , WS_WKV = 62 * MiB  ,
                 WS_WO = 70 * MiB  , WS_WUP = 74 * MiB  , WS_WDN = 138 * MiB  , WS_MEMN = 202 * MiB, WS_KVM = 204 * MiB,
                 WS_ROPE = 205 * MiB, WS_HN = 206 * MiB, WS_YC = 238 * MiB, WS_Y = 270 * MiB, WS_R1 = 334 * MiB, WS_CTL = 498 * MiB, WS_END = 499 * MiB;
constexpr size_t CTL_ZERO_BYTES = 16384;
constexpr int MISC_OFF = 131072 + 320;
constexpr size_t WS_PROJ = WS_R1, WS_OD = WS_R1 + 96 * MiB, WS_U = WS_R1, WS_QM = WS_R1, WS_OM = WS_R1 + 8 * MiB;

struct Params { const float* in[26]; float* out; unsigned char* ws; };
typedef const __attribute__((address_space(4))) Params* KPtr;
__device__ __forceinline__ KPtr kp() { KPtr p = (KPtr)__builtin_amdgcn_kernarg_segment_ptr(); asm volatile("" : "+s"(p)); return p; }

__device__ __forceinline__ unsigned f2bf(float f) { unsigned u = __builtin_bit_cast(unsigned, f); return (u + 0x7fffu + ((u >> 16) & 1u)) >> 16; }
__device__ __forceinline__ unsigned pk2(float lo, float hi) { return f2bf(lo) | (f2bf(hi) << 16); }
__device__ __forceinline__ float bf_lo(unsigned w) { return __builtin_bit_cast(float, w << 16); }
__device__ __forceinline__ float bf_hi(unsigned w) { return __builtin_bit_cast(float, w & 0xffff0000u); }
__device__ __forceinline__ float wave_sum(float v) {
#pragma unroll
    for (int o = 1; o < 64; o <<= 1) v += __shfl_xor(v, o);
    return v;
}
#define LDS_WAIT() asm volatile("s_waitcnt lgkmcnt(0)" ::: "memory")

__device__ __forceinline__ void transpose_item(const float* __restrict__ W, int K, int N, bf16* __restrict__ WT, int ldk, int row_off, LAS float* scr, int item, int lane) {
    const int nblk = N / 32, kb = item / nblk, nb = item % nblk, k0 = 64 * kb, n0 = 32 * nb;
    float tv[32];
#pragma unroll
    for (int i = 0; i < 32; ++i) { const int kk = 2 * i + (lane >> 5); tv[i] = __builtin_nontemporal_load(&W[(size_t)(k0 + kk) * N + n0 + (lane & 31)]); }
#pragma unroll
    for (int i = 0; i < 32; ++i) { const int kk = 2 * i + (lane >> 5); scr[kk * 33 + (lane & 31)] = tv[i]; }
    LDS_WAIT(); asm volatile("" ::: "memory");
    const int c = lane & 7;
#pragma unroll
    for (int j = 0; j < 4; ++j) { const int n = (lane >> 3) + 8 * j; const LAS float* s = scr + (8 * c) * 33 + n;
        v4u o; o.x = pk2(s[0 * 33], s[1 * 33]); o.y = pk2(s[2 * 33], s[3 * 33]); o.z = pk2(s[4 * 33], s[5 * 33]); o.w = pk2(s[6 * 33], s[7 * 33]);
        *(v4u*)(WT + (size_t)(row_off + n0 + n) * ldk + k0 + 8 * c) = o; }
    LDS_WAIT(); asm volatile("" ::: "memory");
}
__device__ __forceinline__ void transpose_matrix(const float* W, int K, int N, bf16* WT, int row_off, LAS float* scr, int gw, int NGW, int lane, int& base, int ldk = 0) {
    if (ldk == 0) ldk = K;
    const int items = (K / 64) * (N / 32);
    int first = (gw - base) % NGW; if (first < 0) first += NGW;
    for (int it = first; it < items; it += NGW) transpose_item(W, K, N, WT, ldk, row_off, scr, it, lane);
    base = (base + items) % NGW;
}

__device__ __forceinline__ void rms_row_bf16(const float* __restrict__ xrow, const float* __restrict__ g, bf16* __restrict__ orow, int lane) {
    const f32x4* xr = (const f32x4*)xrow + lane; const f32x4* gr = (const f32x4*)g + lane;
    f32x4 v[8]; float s = 0.f;
#pragma unroll
    for (int j = 0; j < 8; ++j) { v[j] = xr[64 * j]; s += (v[j].x * v[j].x + v[j].y * v[j].y) + (v[j].z * v[j].z + v[j].w * v[j].w); }
    const float rinv = 1.f / sqrtf(wave_sum(s) * (1.f / DM) + EPS);
    v2u* o8 = (v2u*)orow + lane;
#pragma unroll
    for (int j = 0; j < 8; ++j) { const f32x4 gg = gr[64 * j]; v2u w; w.x = pk2(v[j].x * rinv * gg.x, v[j].y * rinv * gg.y); w.y = pk2(v[j].z * rinv * gg.z, v[j].w * rinv * gg.w); o8[64 * j] = w; }
}
template <bool HIN_F32, bool HOUT_F32>
__device__ __forceinline__ void resid_row(const void* __restrict__ hin, const bf16* __restrict__ y  , const float* __restrict__ gpost, const float* __restrict__ gpre,
                                          void* __restrict__ hout, bf16* __restrict__ hn, int lane) {
    const v2u* yr = (const v2u*)y + lane; const f32x4* gp = (const f32x4*)gpost + lane;
    f32x4 v[8], hh[8]; float s = 0.f;
#pragma unroll
    for (int j = 0; j < 8; ++j) { const v2u w = yr[64 * j]; v[j] = (f32x4){bf_lo(w.x), bf_hi(w.x), bf_lo(w.y), bf_hi(w.y)}; }
    if constexpr (HIN_F32) { const f32x4* hr = (const f32x4*)hin + lane;
#pragma unroll
        for (int j = 0; j < 8; ++j) hh[j] = hr[64 * j];
    } else { const v2u* hr = (const v2u*)hin + lane;
#pragma unroll
        for (int j = 0; j < 8; ++j) { const v2u w = hr[64 * j]; hh[j] = (f32x4){bf_lo(w.x), bf_hi(w.x), bf_lo(w.y), bf_hi(w.y)}; }
    }
#pragma unroll
    for (int j = 0; j < 8; ++j) s += (v[j].x * v[j].x + v[j].y * v[j].y) + (v[j].z * v[j].z + v[j].w * v[j].w);
    const float rinv = 1.f / sqrtf(wave_sum(s) * (1.f / DM) + EPS);
    float s2 = 0.f;
#pragma unroll
    for (int j = 0; j < 8; ++j) { const f32x4 gg = gp[64 * j];
        v[j] = hh[j] + (v[j] * rinv) * gg;
        if constexpr (HOUT_F32) ((f32x4*)hout + lane)[64 * j] = v[j];
        else { v2u w; w.x = pk2(v[j].x, v[j].y); w.y = pk2(v[j].z, v[j].w); ((v2u*)hout + lane)[64 * j] = w; }
        s2 += (v[j].x * v[j].x + v[j].y * v[j].y) + (v[j].z * v[j].z + v[j].w * v[j].w); }
    if (gpre) {
        const float rinv2 = 1.f / sqrtf(wave_sum(s2) * (1.f / DM) + EPS);
        const f32x4* gq = (const f32x4*)gpre + lane; v2u* o8 = (v2u*)hn + lane;
#pragma unroll
        for (int j = 0; j < 8; ++j) { const f32x4 gg = gq[64 * j]; v2u w; w.x = pk2(v[j].x * rinv2 * gg.x, v[j].y * rinv2 * gg.y); w.y = pk2(v[j].z * rinv2 * gg.z, v[j].w * rinv2 * gg.w); o8[64 * j] = w; }
    }
}

template <class Epi>
__device__ __forceinline__ void run_gemm(PG8_LAS unsigned char* lds, int wv, const bf16* A, const bf16* Bt, int M, int N, int K, const Epi& E, int crot = 0  ) {
    pg8::Gemm g{A, Bt, M, N, K}; pg8::StaticOrder S; S.init(M, N, (int)gridDim.x, (int)((blockIdx.x + gridDim.x - (unsigned)crot) % gridDim.x));
    if (EN_GEMM && (EN_EPI < 0 || EN_EPI == Epi::ID)) pg8::gemm_phase<Epi, pg8::StaticOrder, true, true>(lds, g, S, E, wv);
}
template <bool HIN_F32, bool HOUT_F32>
__device__ __forceinline__ void resid_phase(int wv, const void* hin, const bf16* y, const float* gpost, const float* gpre, void* hout, bf16* hn) {
    const int tid = opaque_tid(wv), lane = tid & 63, gw = blockIdx.x * NWAVES + (tid >> 6), NGW = gridDim.x * NWAVES;
    constexpr size_t SIN = HIN_F32 ? 4 : 2, SOUT = HOUT_F32 ? 4 : 2;
    for (int m = gw; m < S_; m += NGW) resid_row<HIN_F32, HOUT_F32>((const char*)hin + (size_t)m * DM * SIN, y + (size_t)m * DM, gpost, gpre, (char*)hout + (size_t)m * DM * SOUT, hn + (size_t)m * DM, lane);
}
#define XB_TMO      128
#define XB_XCNT(j)  (256  + 64 * (j))
#define XB_XSUB(j)  (1280 + 64 * (j))
#define XB_XGEN(j)  (2304 + 64 * (j))
#define XB_TOP      3328
#define XB_TOPGEN   3392
#define XCD_BAR_WORDS 3456
#define XB_SPIN_CAP (1u << 18)

__device__ __forceinline__ unsigned xb_ld(unsigned* p)              { return __hip_atomic_load(p, __ATOMIC_RELAXED, __HIP_MEMORY_SCOPE_AGENT); }
__device__ __forceinline__ unsigned xb_add(unsigned* p, unsigned v) { return __hip_atomic_fetch_add(p, v, __ATOMIC_RELAXED, __HIP_MEMORY_SCOPE_AGENT); }
__device__ __forceinline__ unsigned xb_xcc_id() { return (unsigned)__builtin_amdgcn_s_getreg((3 << 11) | 20) & 0xFu; }
#define XB_SPIN(cond, bar) do { unsigned _sp = 0; while (cond) { __builtin_amdgcn_s_sleep(1); \
    if ((++_sp & 255u) == 0u) { if (xb_ld(&(bar)[XB_TMO])) break; if (_sp > XB_SPIN_CAP) { atomicAdd(&(bar)[XB_TMO], 1u); break; } } } } while (0)

struct XcdBarrier {
    unsigned* bar; unsigned x;
    volatile LAS unsigned* st;
};

__device__ __forceinline__ XcdBarrier xcd_barrier_post(unsigned* bar, volatile LAS unsigned* st) {
    XcdBarrier b; b.bar = bar; b.x = xb_xcc_id(); b.st = st;
    if (threadIdx.x == 0) (void)xb_add(&bar[XB_XCNT(b.x)], 1u);
    return b;
}
__device__ __forceinline__ void xcd_barrier_complete(unsigned* bar, unsigned x, unsigned& nloc, unsigned& nx) {
    const unsigned G = gridDim.x * gridDim.y * gridDim.z;
    unsigned sum, cnt, mine, sp = 0u;
    for (;;) {
        sum = 0u; cnt = 0u; mine = 0u;
#pragma unroll
        for (unsigned j = 0; j < 16; ++j) { const unsigned c = xb_ld(&bar[XB_XCNT(j)]); sum += c; cnt += (c > 0u) ? 1u : 0u; mine = (j == x) ? c : mine; }
        if (sum == G) break;
        __builtin_amdgcn_s_sleep(1);
        if ((++sp & 255u) == 0u) { if (xb_ld(&bar[XB_TMO])) break; if (sp > XB_SPIN_CAP) { atomicAdd(&bar[XB_TMO], 1u); break; } }
    }
    nloc = mine > 0u ? mine : 1u; nx = cnt > 0u ? cnt : 1u;
}

__device__ __forceinline__ void xcd_barrier(const XcdBarrier& b, bool leader) {
    asm volatile("s_waitcnt vmcnt(0)" ::: "memory");
    __syncthreads();
    if (leader) {
        unsigned* bar = b.bar;
        __builtin_amdgcn_s_waitcnt(0);
        unsigned nloc = b.st[0], nx = b.st[1];
        if (nloc == 0u) { xcd_barrier_complete(bar, b.x, nloc, nx); b.st[0] = nloc; b.st[1] = nx; }
        const unsigned old = xb_add(&bar[XB_XSUB(b.x)], 1u);
        const unsigned gen = old / nloc;
        if (old + 1u == (gen + 1u) * nloc) {
            __builtin_amdgcn_fence(__ATOMIC_RELEASE, "agent");
            asm volatile("s_waitcnt vmcnt(0)" ::: "memory");
            const unsigned og = xb_add(&bar[XB_TOP], 1u);
            const unsigned tg = og / nx;
            if (og + 1u != (tg + 1u) * nx) XB_SPIN(xb_ld(&bar[XB_TOP]) < (tg + 1u) * nx, bar);
            __builtin_amdgcn_fence(__ATOMIC_ACQUIRE, "agent");
            xb_add(&bar[XB_XGEN(b.x)], 1u);
            asm volatile("s_waitcnt vmcnt(0)" ::: "memory");
        } else {
            XB_SPIN(xb_ld(&bar[XB_XGEN(b.x)]) == gen, bar);
            __builtin_amdgcn_fence(__ATOMIC_ACQUIRE, "agent");
            asm volatile("s_waitcnt vmcnt(0)" ::: "memory");
        }
    }
    __syncthreads();
}

__global__ void __launch_bounds__(NTHREADS, 2) fwd_megakernel(Params P) {
    extern __shared__ __attribute__((aligned(16))) unsigned char lds[];
    cg::grid_group grid = cg::this_grid();
    const int wave_s = __builtin_amdgcn_readfirstlane((int)threadIdx.x >> 6);
    {
        volatile LAS unsigned* misc0 = (volatile LAS unsigned*)((LAS unsigned char*)lds + MISC_OFF);
        if (threadIdx.x < 16) misc0[threadIdx.x] = 0u;
        __syncthreads();
        (void)xcd_barrier_post((unsigned*)(kp()->ws + WS_CTL), misc0 + 8);
    }
#define SLOT_BEGIN(c0_) { int gqs_ = (int)gridDim.x; asm volatile("" : "+s"(gqs_)); const int c0s_ = (gqs_ == 256) ? (c0_) : 0; if (bx >= c0s_) { PHASE_IDS(); LAS float* scr = (LAS float*)(ldsp + wave * 16384); const int gws = (bx - c0s_) * NWAVES + wave, NGWS = (gqs_ - c0s_) * NWAVES; int base = 0; (void)gw;
#define SLOT_T(W_, K_, N_, WT_, LDK_) transpose_matrix(W_, K_, N_, WT_, 0, scr, gws, NGWS, lane, base, LDK_)
#define SLOT_END() } }
#define GSYNC() do { XcdBarrier b_; b_.bar = (unsigned*)(kp()->ws + WS_CTL); b_.x = xb_xcc_id(); b_.st = (volatile LAS unsigned*)((LAS unsigned char*)lds + MISC_OFF) + 8; xcd_barrier(b_, opaque_tid(wave_s) == 0); } while (0)
    PG8_LAS unsigned char* ldsp = (PG8_LAS unsigned char*)lds;
    const int G = gridDim.x, bx = blockIdx.x, NGW = G * NWAVES;
#define PHASE_IDS() const int tid = opaque_tid(wave_s), lane = tid & 63, wave = __builtin_amdgcn_readfirstlane(tid >> 6), gw = bx * NWAVES + wave; (void)lane; (void)gw
#define WSB (kp()->ws)
#define X_IN (kp()->in[0])
#define MEM_IN (kp()->in[1])
#define Win_t0 ((bf16*)(WSB + WS_WIN0))
#define Win_t1 ((bf16*)(WSB + WS_WIN1))
#define Wout_t0 ((bf16*)(WSB + WS_WOUT0))
#define Wout_t1 ((bf16*)(WSB + WS_WOUT1))
#define MEMN ((bf16*)(WSB + WS_MEMN))
#define KVM ((bf16*)(WSB + WS_KVM))
#define ROPE ((float*)(WSB + WS_ROPE))
#define HN ((bf16*)(WSB + WS_HN))
#define YC ((bf16*)(WSB + WS_YC))
#define Y_BUF ((bf16*)(WSB + WS_Y))
#define PROJ ((bf16*)(WSB + WS_PROJ))
#define OD ((bf16*)(WSB + WS_OD))
#define U_BUF ((bf16*)(WSB + WS_U))
#define QM ((bf16*)(WSB + WS_QM))
#define OM ((bf16*)(WSB + WS_OM))
#define H_BUF (kp()->out)
#define HB_BUF ((bf16*)(WSB + WS_Y + 32 * MiB))
    for (int rep_ = 0; rep_ < (PROBE == 1 ? 2 : 1); ++rep_) {
        PHASE_IDS();
        LAS float* scr = (LAS float*)(ldsp + wave * 16384);
        int base = 0;
        transpose_matrix(kp()->in[2], DM, EVEN_IN, Win_t0, 0, scr, gw, NGW, lane, base);
        for (int l = 0; l < 2; ++l) {
            transpose_matrix(kp()->in[19] + (size_t)l * DM * MEMW, DM, MEMW, (bf16*)(WSB + WS_WKV + l * 4 * MiB), 0, scr, gw, NGW, lane, base);
            transpose_matrix(kp()->in[20] + (size_t)l * DM * MEMW, DM, MEMW, (bf16*)(WSB + WS_WKV + l * 4 * MiB), MEMW, scr, gw, NGW, lane, base);
        }
        for (int i = bx * NTHREADS + tid; i < S_ * 16; i += G * NTHREADS) {
            const int pos = i >> 4, k = i & 15;
            const float inv = (float)exp2(-(double)k * (18.931568569324174 / 16.0));
            const float ang = (float)pos * inv;
            double t = (double)ang * 0.15915494309189535; t -= rint(t);
            const float fr = (float)t;
            ROPE[2 * i] = __builtin_amdgcn_cosf(fr); ROPE[2 * i + 1] = __builtin_amdgcn_sinf(fr);
        }
        for (int m = gw; m < 2 * MEMLEN; m += NGW) { const int l = m / MEMLEN, r = m % MEMLEN;
            rms_row_bf16(MEM_IN + (size_t)r * DM, kp()->in[15] + l * DM, MEMN + (size_t)m * DM, lane); }
        for (int m = gw; m < S_; m += NGW) rms_row_bf16(X_IN + (size_t)m * DM, kp()->in[13], HN + (size_t)m * DM, lane);
    }
    if (gridDim.x == 0x7fffffffu) grid.sync();
    GSYNC();

    for (int layer = 0; layer < 2; ++layer) {

        if (layer == 0) {
            run_gemm(ldsp, wave_s, HN, Win_t0, S_, EVEN_IN, DM, pg8::EpiBf16Rope{PROJ, EVEN_IN, ROPE, 24, 34});
            for (int l = 0; l < 2; ++l)
                run_gemm(ldsp, wave_s, MEMN + (size_t)l * MEMLEN * DM, (const bf16*)(WSB + WS_WKV + l * 4 * MiB), MEMLEN, 2 * MEMW, DM, pg8::EpiBf16<0>{KVM + (size_t)l * MEMLEN * 2 * MEMW, 2 * MEMW}, 64 + 4 * l);
            SLOT_BEGIN(64)
                SLOT_T(kp()->in[3], DM, DM, Wout_t0, 0);
                SLOT_T(kp()->in[18], DM, MEMW, (bf16*)(WSB + WS_WQ), 0);
                SLOT_T(kp()->in[21], MEMW, DM, (bf16*)(WSB + WS_WO), 0);
                SLOT_T(kp()->in[24], DM, DFF, (bf16*)(WSB + WS_WUP), 0);
                SLOT_T(kp()->in[25], DFF, DM, (bf16*)(WSB + WS_WDN), 0);
            SLOT_END()
        } else {
            run_gemm(ldsp, wave_s, HN, Win_t1, S_, ODD_IN, DM, pg8::EpiBf16Rope{PROJ, ODD_IN, ROPE, 0, 32});
        }
        GSYNC();
        if (layer == 0) {
            PHASE_IDS();
            const int r32 = lane & 31, hi = lane >> 5;
            for (int u = bx; u < 512; u += G) {
                const int kind = u >> 8, uu = u & 255, hd = uu & 7, qb = uu >> 3;
                if (kind == 0) {
                    LAS float* tab = (LAS float*)(ldsp + NA_TAB_OFF);
                    __syncthreads();
                    if (tid < 465) tab[tid] = kp()->in[4][hd * 465 + tid] * (1.f / att::SCALE);
                    __syncthreads();
                    const int i0 = 4 * qb, kr0 = min(max(i0 - 4, 0), 120), thi = min(max(i0 - 1, 0), 120) + 7;
                    int NT = thi - kr0 + 1; NT += NT & 1;
                    const int qi = i0 + (wave >> 1), qj = 32 * (wave & 1) + r32;
                    att::ModNA mod{kr0, qi, qj, min(max(qi - 4, 0), 120), min(max(qj - 8, 0), 48), hi, tab};
                    if (EN_NA) att::attn_body<EVEN_IN, EVEN_IN, DM, att::ModNA>(PROJ + (size_t)(256 * qb) * EVEN_IN + hd * 128, PROJ + (size_t)(kr0 * 64) * EVEN_IN + 1024 + hd * 128,
                        PROJ + (size_t)(kr0 * 64) * EVEN_IN + 2048 + hd * 128, YC + (size_t)(256 * qb) * DM + hd * 128, NT, (char*)lds, wave_s, mod, -1e30f, 0.f);
                } else {
                    const int q0 = 256 * qb, ks = max(q0 - 128, 0), ke = min(q0 + 384, S_), NT = (ke - ks) / 64, kvh = hd >> 2;
                    att::ModSWA mod{q0 + wave * 32 + r32 - ks, hi, q0 + wave * 32 - ks};
                    const float sink = kp()->in[5][hd];
                    if (EN_SWA) att::attn_body<EVEN_IN, EVEN_IN, DM, att::ModSWA>(PROJ + (size_t)q0 * EVEN_IN + 3072 + hd * 128, PROJ + (size_t)ks * EVEN_IN + 4096 + kvh * 128,
                        PROJ + (size_t)ks * EVEN_IN + 4352 + kvh * 128, YC + (size_t)q0 * DM + 1024 + hd * 128, NT, (char*)lds, wave_s, mod, sink * (1.f / att::SCALE), 1.f);
                }
            }
        } else {
            for (int rep_ = 0; rep_ < (PROBE == 2 ? 2 : 1); ++rep_)
            for (int u = bx; u < 1024; u += G) {
                const int i = u >> 8, c = u & 255, combo = 2 * (c & 7) + (i >> 1), qb = (i & 1) * 32 + (c >> 3);
                const int h = combo >> 1;
                if (EN_DIFF) att::attn_dv256_body<ODD_IN, ODD_IN, ODD_IN, 4096>(PROJ + (size_t)(128 * qb) * ODD_IN + combo * 128, PROJ + 2048 + combo * 128,
                    PROJ + 4096 + h * 256, OD + (size_t)(128 * qb) * 4096 + combo * 256, S_ / 64, (char*)lds, wave_s);
            }
            if (G == 256) { asm volatile("s_waitcnt vmcnt(0)" ::: "memory"); __syncthreads(); } else GSYNC();
            {
                PHASE_IDS();
                const float a1 = kp()->in[8][lane] * kp()->in[9][lane] + kp()->in[8][lane + 64] * kp()->in[9][lane + 64];
                const float a2 = kp()->in[10][lane] * kp()->in[11][lane] + kp()->in[10][lane + 64] * kp()->in[11][lane + 64];
                const float lam = expf(wave_sum(a1)) - expf(wave_sum(a2)) + LAMBDA_INIT1;
                const f32x4 gg = ((const f32x4*)kp()->in[12])[lane];
                const int nit = (G == 256) ? 256 : S_ * 8;
                for (int it = (G == 256) ? wave : gw; it < nit; it += (G == 256) ? NWAVES : NGW) {
                    const int row = (G == 256) ? 128 * ((it >> 7) * 32 + (bx >> 3)) + (it & 127) : it >> 3, h = (G == 256) ? (bx & 7) : it & 7;
                    const v2u o0 = *((const v2u*)(OD + (size_t)row * 4096 + (h * 2) * 256) + lane), o1 = *((const v2u*)(OD + (size_t)row * 4096 + (h * 2 + 1) * 256) + lane);
                    f32x4 d; d.x = bf_lo(o0.x) - lam * bf_lo(o1.x); d.y = bf_hi(o0.x) - lam * bf_hi(o1.x); d.z = bf_lo(o0.y) - lam * bf_lo(o1.y); d.w = bf_hi(o0.y) - lam * bf_hi(o1.y);
                    const float ss = wave_sum((d.x * d.x + d.y * d.y) + (d.z * d.z + d.w * d.w));
                    const float rinv = (1.f - LAMBDA_INIT1) / sqrtf(ss * (1.f / 256.f) + EPS);
                    v2u w; w.x = pk2(d.x * rinv * gg.x, d.y * rinv * gg.y); w.y = pk2(d.z * rinv * gg.z, d.w * rinv * gg.w);
                    *((v2u*)(YC + (size_t)row * DM + h * 256) + lane) = w;
                }
            }
        }
        GSYNC();
        run_gemm(ldsp, wave_s, YC, (layer == 0 ? Wout_t0 : Wout_t1), S_, DM, DM, pg8::EpiBf16<0>{Y_BUF, DM});
        GSYNC();
        if (layer == 0) resid_phase<true, false>(wave_s, X_IN, Y_BUF, kp()->in[14], kp()->in[16], HB_BUF, HN);
        else resid_phase<false, false>(wave_s, HB_BUF, Y_BUF, kp()->in[14] + DM, kp()->in[16] + DM, HB_BUF, HN);
        GSYNC();
        run_gemm(ldsp, wave_s, HN, (const bf16*)(WSB + WS_WQ + layer * 2 * MiB), S_, MEMW, DM, pg8::EpiBf16<0>{QM, MEMW});
        if (layer == 0) {
            SLOT_BEGIN(64)
                SLOT_T(kp()->in[6], DM, ODD_IN, Win_t1, 0);
                SLOT_T(kp()->in[7], DM, DM, Wout_t1, 0);
                SLOT_T(kp()->in[18] + (size_t)DM * MEMW, DM, MEMW, (bf16*)(WSB + WS_WQ + 2 * MiB), 0);
                SLOT_T(kp()->in[21] + (size_t)MEMW * DM, MEMW, DM, (bf16*)(WSB + WS_WO + 2 * MiB), 0);
                SLOT_T(kp()->in[24] + (size_t)DM * DFF, DM / 2, DFF, (bf16*)(WSB + WS_WUP + 32 * MiB), DM);
            SLOT_END()
        } else {
            SLOT_BEGIN(64)
                SLOT_T(kp()->in[24] + (size_t)DM * DFF + (size_t)(DM / 2) * DFF, DM / 2, DFF, (bf16*)(WSB + WS_WUP + 32 * MiB) + DM / 2, DM);
                SLOT_T(kp()->in[25] + (size_t)DFF * DM, DFF, DM, (bf16*)(WSB + WS_WDN + 32 * MiB), 0);
            SLOT_END()
        }
        GSYNC();
        for (int u = bx; u < 128; u += G) {
            const int hd = u & 3, qb = u >> 2; const bf16* kv = KVM + (size_t)layer * MEMLEN * 2 * MEMW;
            if (EN_MEM) att::attn_body<MEMW, 2 * MEMW, MEMW, att::ModNone>(QM + (size_t)(256 * qb) * MEMW + hd * 128, kv + hd * 128, kv + MEMW + hd * 128,
                OM + (size_t)(256 * qb) * MEMW + hd * 128, MEMLEN / 64, (char*)lds, wave_s, att::ModNone{}, -1e30f, 0.f);
        }
        GSYNC();
        run_gemm(ldsp, wave_s, OM, (const bf16*)(WSB + WS_WO + layer * 2 * MiB), S_, DM, MEMW, pg8::EpiBf16<0>{Y_BUF, DM});
        GSYNC();
        resid_phase<false, false>(wave_s, HB_BUF, Y_BUF, kp()->in[17] + layer * DM, kp()->in[22] + layer * DM, HB_BUF, HN);
        GSYNC();
        for (int rep_ = 0; rep_ < ((PROBE == 3 && layer == 0) ? 2 : 1); ++rep_) {
        run_gemm(ldsp, wave_s, HN, (const bf16*)(WSB + WS_WUP + layer * 32 * MiB), S_, DFF, DM, pg8::EpiBf16<1>{U_BUF, DFF});
        GSYNC();
        run_gemm(ldsp, wave_s, U_BUF, (const bf16*)(WSB + WS_WDN + layer * 32 * MiB), S_, DM, DFF, pg8::EpiBf16<0>{Y_BUF, DM});
        GSYNC();
        }
        if (layer == 0) resid_phase<false, false>(wave_s, HB_BUF, Y_BUF, kp()->in[23], kp()->in[13] + DM, HB_BUF, HN);
        else resid_phase<false, true>(wave_s, HB_BUF, Y_BUF, kp()->in[23] + DM, nullptr, H_BUF, HN);
        if (layer == 0) GSYNC();
    }
}

extern "C" void kernel_launch(void* const* d_in, const int* in_sizes, int n_in, void* d_out, int out_size, void* d_ws, size_t ws_size, hipStream_t stream) {
    static int grid = 0;
    if (grid == 0) {
        if (n_in != 26 || out_size != S_ * DM || ws_size < WS_END) { fprintf(stderr, "kernel_launch: unexpected shapes: n_in %d out %d ws %zu (need %zu)\n", n_in, out_size, ws_size, (size_t)WS_END); grid = -1; return; }
        int dev = 0, cus = 0, per_cu = 0;
        hipGetDevice(&dev); hipDeviceGetAttribute(&cus, hipDeviceAttributeMultiprocessorCount, dev);
        if (hipFuncSetAttribute((const void*)fwd_megakernel, hipFuncAttributeMaxDynamicSharedMemorySize, LDS_BYTES) != hipSuccess) { fprintf(stderr, "kernel_launch: hipFuncSetAttribute failed\n"); grid = -1; return; }
        if (hipOccupancyMaxActiveBlocksPerMultiprocessor(&per_cu, (const void*)fwd_megakernel, NTHREADS, LDS_BYTES) != hipSuccess || per_cu < 1) { fprintf(stderr, "kernel_launch: occupancy query says %d\n", per_cu); per_cu = 1; }
        (void)hipGetLastError();
        grid = cus;
        if (grid != 256) fprintf(stderr, "kernel_launch: %d CUs (expected 256)\n", grid);
    }
    if (grid < 0) return;
    if (hipMemsetAsync((char*)d_ws + WS_CTL, 0, CTL_ZERO_BYTES, stream) != hipSuccess) { fprintf(stderr, "kernel_launch: memset failed\n"); return; }
    Params p{};
    for (int i = 0; i < 26; ++i) p.in[i] = (const float*)d_in[i];
    p.out = (float*)d_out; p.ws = (unsigned char*)d_ws;
    void* args[] = {&p};
    hipError_t e = hipLaunchCooperativeKernel((const void*)fwd_megakernel, dim3(grid), dim3(NTHREADS), args, LDS_BYTES, stream);
    if (e != hipSuccess) fprintf(stderr, "kernel_launch: cooperative launch failed: %s (grid %d)\n", hipGetErrorString(e), grid);
}
```
